# Optimizing an MI355X kernel written in HIP

```python
import math
import jax, jax.numpy as jnp
from jax import lax
import numpy as np

D_MODEL = 1024
BATCH = 8
SEQ = 2048
DEPTH = 4

GRID_W = 64
CTX_LEN = 256
N_MIXERS = 3
Q_BLOCK = 128
ROPE_THETA = 10000.0
LN_EPS = 1e-5
RMS_EPS = 1e-6
NEG_INF = -1e30

A_HEADS = 8
A_KV_HEADS = 2
A_HEAD_DIM = 128
B_HEADS = 16
B_KV_HEADS = 4
B_HEAD_DIM = 64
WINDOW = 128
C_HEADS = 8
C_HEAD_DIM = 64
N_GROUPS = 4
EXPERTS_PER_GROUP = 8
EXPERT_FF = 512
TOP_K = 2

N_A = (DEPTH + 2) // 3
N_B = (DEPTH + 1) // 3
N_C = DEPTH // 3

DEEPNORM_ALPHA = (2.0 * DEPTH) ** 0.25
DEEPNORM_BETA = (8.0 * DEPTH) ** -0.25

kernel_name = 'hybrid_diffusion_backbone'


def layer_norm(x, g, b):
    xf = x.astype(jnp.float32)
    mu = jnp.mean(xf, axis=-1, keepdims=True)
    var = jnp.mean(jnp.square(xf - mu), axis=-1, keepdims=True)
    y = (xf - mu) * lax.rsqrt(var + LN_EPS)
    return (y * g.astype(jnp.float32) + b.astype(jnp.float32)).astype(x.dtype)


def rms_norm(x, g):
    xf = x.astype(jnp.float32)
    y = xf * lax.rsqrt(jnp.mean(jnp.square(xf), axis=-1, keepdims=True) + RMS_EPS)
    return (y * g.astype(jnp.float32)).astype(x.dtype)


def axial_rope(n_tokens, head_dim):
    rows = n_tokens // GRID_W
    row = jnp.broadcast_to(jnp.arange(rows, dtype=jnp.float32)[:, None], (rows, GRID_W)).reshape(-1)
    col = jnp.broadcast_to(jnp.arange(GRID_W, dtype=jnp.float32)[None, :], (rows, GRID_W)).reshape(-1)
    n_freq = head_dim // 4
    inv = ROPE_THETA ** (-jnp.arange(n_freq, dtype=jnp.float32) / n_freq)
    ang = jnp.stack([row[:, None] * inv, col[:, None] * inv], axis=1)
    return jnp.cos(ang), jnp.sin(ang)


def apply_rope(x, cos, sin):
    nf = x.shape[-1] // 4
    xs = x.reshape(x.shape[:-1] + (2, 2, nf))
    x1, x2 = xs[..., 0, :], xs[..., 1, :]
    c, s = cos.astype(x.dtype), sin.astype(x.dtype)
    out = jnp.stack([x1 * c - x2 * s, x1 * s + x2 * c], axis=-2)
    return out.reshape(x.shape)


def to_blocks(x, axis):
    n = x.shape[axis] // Q_BLOCK
    x = x.reshape(x.shape[:axis] + (n, Q_BLOCK) + x.shape[axis + 1:])
    return jnp.moveaxis(x, axis, 0)


def from_blocks(x, axis):
    x = jnp.moveaxis(x, 0, axis)
    return x.reshape(x.shape[:axis] + (-1,) + x.shape[axis + 2:])


def _qkv_gqa(h, w_qkv, n_heads, n_kv, head_dim):
    b, t, _ = h.shape
    g = n_heads // n_kv
    q, k, v = jnp.split(h @ w_qkv, [n_heads * head_dim, (n_heads + n_kv) * head_dim], axis=-1)
    q = q.reshape(b, t, n_kv, g, head_dim).transpose(0, 2, 3, 1, 4)
    k = k.reshape(b, t, n_kv, head_dim).transpose(0, 2, 1, 3)
    v = v.reshape(b, t, n_kv, head_dim).transpose(0, 2, 1, 3)
    return q, k, v


def _merge_gqa(o):
    b, hkv, g, t, d = o.shape
    return o.transpose(0, 3, 1, 2, 4).reshape(b, t, hkv * g * d)


def _gqa_attend(q, k, v, scale):
    s = jnp.einsum('bhgqd,bhkd->bhgqk', q, k).astype(jnp.float32) * scale
    p = jax.nn.softmax(s, axis=-1).astype(v.dtype)
    return jnp.einsum('bhgqk,bhkd->bhgqd', p, v)


def mixer_a(h_lat, h_ctx, w_qkv, q_gain, k_gain, w_o, need_ctx):
    cos, sin = axial_rope(h_lat.shape[1], A_HEAD_DIM)
    scale = A_HEAD_DIM ** -0.5
    q, k, v = _qkv_gqa(h_lat, w_qkv, A_HEADS, A_KV_HEADS, A_HEAD_DIM)
    q = apply_rope(rms_norm(q, q_gain), cos, sin)
    k = apply_rope(rms_norm(k, k_gain), cos, sin)
    qc, kc, vc = _qkv_gqa(h_ctx, w_qkv, A_HEADS, A_KV_HEADS, A_HEAD_DIM)
    qc, kc = rms_norm(qc, q_gain), rms_norm(kc, k_gain)
    k_all = jnp.concatenate([k, kc], axis=2)
    v_all = jnp.concatenate([v, vc], axis=2)
    o = lax.map(lambda qb: _gqa_attend(qb, k_all, v_all, scale), to_blocks(q, 3))
    o_lat = _merge_gqa(from_blocks(o, 3)) @ w_o
    o_ctx = _merge_gqa(_gqa_attend(qc, kc, vc, scale)) @ w_o if need_ctx else None
    return o_lat, o_ctx


def mixer_b(h_lat, h_ctx, w_qkv, sink, w_o, need_ctx):
    s_len = h_lat.shape[1]
    cos, sin = axial_rope(s_len, B_HEAD_DIM)
    scale = B_HEAD_DIM ** -0.5
    g = B_HEADS // B_KV_HEADS
    q, k, v = _qkv_gqa(h_lat, w_qkv, B_HEADS, B_KV_HEADS, B_HEAD_DIM)
    q, k = apply_rope(q, cos, sin), apply_rope(k, cos, sin)
    qc, kc, vc = _qkv_gqa(h_ctx, w_qkv, B_HEADS, B_KV_HEADS, B_HEAD_DIM)
    n_ctx = kc.shape[2]
    span = Q_BLOCK + 2 * WINDOW
    pad = ((0, 0), (0, 0), (WINDOW, WINDOW), (0, 0))
    k_pad, v_pad = jnp.pad(k, pad), jnp.pad(v, pad)
    sink_l = sink.astype(jnp.float32).reshape(1, B_KV_HEADS, g, 1, 1)
    offs_q = jnp.arange(Q_BLOCK)
    offs_k = jnp.arange(span)
    ctx_valid = jnp.ones((Q_BLOCK, n_ctx), dtype=bool)

    def with_sink(s):
        return jnp.concatenate([s, jnp.broadcast_to(sink_l, s.shape[:-1] + (1,))], axis=-1)

    def block(args):
        j, qb = args
        start = j * Q_BLOCK
        kb = lax.dynamic_slice_in_dim(k_pad, start, span, axis=2)
        vb = lax.dynamic_slice_in_dim(v_pad, start, span, axis=2)
        qpos = start + offs_q
        kpos = start - WINDOW + offs_k
        valid = (jnp.abs(qpos[:, None] - kpos[None, :]) <= WINDOW) & ((kpos >= 0) & (kpos < s_len))[None, :]
        valid = jnp.concatenate([valid, ctx_valid], axis=1)
        kk = jnp.concatenate([kb, kc], axis=2)
        vv = jnp.concatenate([vb, vc], axis=2)
        s = jnp.einsum('bhgqd,bhkd->bhgqk', qb, kk).astype(jnp.float32) * scale
        s = jnp.where(valid, s, NEG_INF)
        p = jax.nn.softmax(with_sink(s), axis=-1)[..., :-1].astype(vv.dtype)
        return jnp.einsum('bhgqk,bhkd->bhgqd', p, vv)

    o = lax.map(block, (jnp.arange(s_len // Q_BLOCK), to_blocks(q, 3)))
    o_lat = _merge_gqa(from_blocks(o, 3)) @ w_o
    o_ctx = None
    if need_ctx:
        s = jnp.einsum('bhgqd,bhkd->bhgqk', qc, kc).astype(jnp.float32) * scale
        p = jax.nn.softmax(with_sink(s), axis=-1)[..., :-1].astype(vc.dtype)
        o_ctx = _merge_gqa(jnp.einsum('bhgqk,bhkd->bhgqd', p, vc)) @ w_o
    return o_lat, o_ctx


def _qkv_diff(h, w_qkv):
    b, t, _ = h.shape
    q, k, v = jnp.split(h @ w_qkv, 3, axis=-1)
    q = q.reshape(b, t, C_HEADS, 2, C_HEAD_DIM).transpose(0, 2, 3, 1, 4)
    k = k.reshape(b, t, C_HEADS, 2, C_HEAD_DIM).transpose(0, 2, 3, 1, 4)
    v = v.reshape(b, t, C_HEADS, 2 * C_HEAD_DIM).transpose(0, 2, 1, 3)
    return q, k, v


def _diff_attend(q, k, v, lam, scale):
    s = jnp.einsum('bhiqd,bhikd->bhiqk', q, k).astype(jnp.float32) * scale
    p = jax.nn.softmax(s, axis=-1)
    a = (p[:, :, 0] - lam * p[:, :, 1]).astype(v.dtype)
    return jnp.einsum('bhqk,bhkd->bhqd', a, v)


def _merge_diff(o, subln_gain, lam_init):
    o = rms_norm(o, subln_gain) * (1.0 - lam_init)
    b, h, t, d = o.shape
    return o.transpose(0, 2, 1, 3).reshape(b, t, h * d)


def mixer_c(h_lat, h_ctx, w_qkv, lam_q1, lam_k1, lam_q2, lam_k2, subln_gain, w_o, lam_init, need_ctx):
    cos, sin = axial_rope(h_lat.shape[1], C_HEAD_DIM)
    scale = C_HEAD_DIM ** -0.5
    lam = (jnp.exp(jnp.sum(lam_q1.astype(jnp.float32) * lam_k1.astype(jnp.float32)))
           - jnp.exp(jnp.sum(lam_q2.astype(jnp.float32) * lam_k2.astype(jnp.float32))) + lam_init)
    q, k, v = _qkv_diff(h_lat, w_qkv)
    q, k = apply_rope(q, cos, sin), apply_rope(k, cos, sin)
    qc, kc, vc = _qkv_diff(h_ctx, w_qkv)
    k_all = jnp.concatenate([k, kc], axis=3)
    v_all = jnp.concatenate([v, vc], axis=2)
    o = lax.map(lambda qb: _diff_attend(qb, k_all, v_all, lam, scale), to_blocks(q, 3))
    o_lat = _merge_diff(from_blocks(o, 2), subln_gain, lam_init) @ w_o
    o_ctx = _merge_diff(_diff_attend(qc, kc, vc, lam, scale), subln_gain, lam_init) @ w_o if need_ctx else None
    return o_lat, o_ctx


def hier_moe(h, w_group, b_group, w_expert, b_expert, w_gate, w_up, w_down):
    shp = h.shape
    t = h.reshape(-1, shp[-1])
    g_logits = (t @ w_group + b_group).astype(jnp.float32)
    g_sel = jnp.argmax(g_logits, axis=-1)
    g_prob = jnp.take_along_axis(jax.nn.softmax(g_logits, axis=-1), g_sel[:, None], axis=-1)
    e_logits = (t @ w_expert + b_expert).astype(jnp.float32).reshape(-1, N_GROUPS, EXPERTS_PER_GROUP)
    e_in_group = jnp.take_along_axis(e_logits, g_sel[:, None, None], axis=1)[:, 0]
    top_v, top_i = lax.top_k(e_in_group, TOP_K)
    top_w = jax.nn.softmax(top_v, axis=-1) * g_prob
    e_gate = jnp.sum(jax.nn.one_hot(top_i, EXPERTS_PER_GROUP, dtype=jnp.float32) * top_w[..., None], axis=1)
    combine = (jax.nn.one_hot(g_sel, N_GROUPS, dtype=jnp.float32)[:, :, None] * e_gate[:, None, :]).astype(t.dtype)
    y = jnp.zeros_like(t)
    for g in range(N_GROUPS):
        a = jnp.einsum('nd,edf->nef', t, w_gate[g])
        u = jnp.einsum('nd,edf->nef', t, w_up[g])
        hid = jax.nn.silu(a) * u * combine[:, g, :, None]
        y = y + jnp.einsum('nef,efd->nd', hid, w_down[g])
    return y.reshape(shp)


def setup_inputs(seed: int = 0) -> dict:
    key = jax.random.key(seed)
    ks = iter(jax.random.split(key, 32))
    D = D_MODEL

    def nrm(shape, scale):
        return jax.random.normal(next(ks), shape, jnp.float32) * scale

    a_qkv = (A_HEADS + 2 * A_KV_HEADS) * A_HEAD_DIM
    b_qkv = (B_HEADS + 2 * B_KV_HEADS) * B_HEAD_DIM
    c_qkv = 3 * 2 * C_HEADS * C_HEAD_DIM
    n_exp = N_GROUPS * EXPERTS_PER_GROUP
    return {
        'x': nrm((BATCH, SEQ, D), 1.0),
        'c': nrm((BATCH, D), 1.0),
        'ctx': nrm((BATCH, CTX_LEN, D), 1.0),
        'c_ctx': nrm((D,), 1.0),
        'w_mod': nrm((DEPTH, D, 6 * D), 0.5 * D ** -0.5),
        'b_mod': nrm((DEPTH, 6 * D), 0.02),
        'ln_gain': 1.0 + nrm((DEPTH, 2, D), 0.02),
        'ln_bias': nrm((DEPTH, 2, D), 0.02),
        'a_w_qkv': nrm((N_A, D, a_qkv), D ** -0.5),
        'a_q_gain': 1.0 + nrm((N_A, A_HEAD_DIM), 0.02),
        'a_k_gain': 1.0 + nrm((N_A, A_HEAD_DIM), 0.02),
        'a_w_o': nrm((N_A, A_HEADS * A_HEAD_DIM, D), DEEPNORM_BETA * (A_HEADS * A_HEAD_DIM) ** -0.5),
        'b_w_qkv': nrm((N_B, D, b_qkv), D ** -0.5),
        'b_sink': nrm((N_B, B_HEADS), 0.5),
        'b_w_o': nrm((N_B, B_HEADS * B_HEAD_DIM, D), DEEPNORM_BETA * (B_HEADS * B_HEAD_DIM) ** -0.5),
        'c_w_qkv': nrm((N_C, D, c_qkv), D ** -0.5),
        'c_lam_q1': nrm((N_C, C_HEAD_DIM), 0.1),
        'c_lam_k1': nrm((N_C, C_HEAD_DIM), 0.1),
        'c_lam_q2': nrm((N_C, C_HEAD_DIM), 0.1),
        'c_lam_k2': nrm((N_C, C_HEAD_DIM), 0.1),
        'c_subln_gain': 1.0 + nrm((N_C, 2 * C_HEAD_DIM), 0.02),
        'c_w_o': nrm((N_C, 2 * C_HEADS * C_HEAD_DIM, D), DEEPNORM_BETA * (2 * C_HEADS * C_HEAD_DIM) ** -0.5),
        'moe_w_group': nrm((DEPTH, D, N_GROUPS), D ** -0.5),
        'moe_b_group': nrm((DEPTH, N_GROUPS), 0.01),
        'moe_w_expert': nrm((DEPTH, D, n_exp), D ** -0.5),
        'moe_b_expert': nrm((DEPTH, n_exp), 0.01),
        'moe_w_gate': nrm((DEPTH, N_GROUPS, EXPERTS_PER_GROUP, D, EXPERT_FF), D ** -0.5),
        'moe_w_up': nrm((DEPTH, N_GROUPS, EXPERTS_PER_GROUP, D, EXPERT_FF), D ** -0.5),
        'moe_w_down': nrm((DEPTH, N_GROUPS, EXPERTS_PER_GROUP, EXPERT_FF, D), DEEPNORM_BETA * EXPERT_FF ** -0.5),
    }


def reference(x, c, ctx, c_ctx, w_mod, b_mod, ln_gain, ln_bias,
              a_w_qkv, a_q_gain, a_k_gain, a_w_o,
              b_w_qkv, b_sink, b_w_o,
              c_w_qkv, c_lam_q1, c_lam_k1, c_lam_q2, c_lam_k2, c_subln_gain, c_w_o,
              moe_w_group, moe_b_group, moe_w_expert, moe_b_expert, moe_w_gate, moe_w_up, moe_w_down):
    n_ctx = ctx.shape[1]
    xl, xc = x, ctx
    silu_c = jax.nn.silu(c)
    silu_cc = jax.nn.silu(c_ctx)
    for i in range(DEPTH):
        need_ctx = i < DEPTH - 1
        m_lat = (silu_c @ w_mod[i] + b_mod[i])[:, None, :]
        m_ctx = (silu_cc @ w_mod[i] + b_mod[i])[None, None, :]
        sh1, sc1, g1, sh2, sc2, g2 = jnp.split(m_lat, 6, axis=-1)
        csh1, csc1, cg1, csh2, csc2, cg2 = jnp.split(m_ctx, 6, axis=-1)
        h_lat = xl * (1.0 + sc1) + sh1
        h_ctx = xc * (1.0 + csc1) + csh1
        kind, j = i % N_MIXERS, i // N_MIXERS
        if kind == 0:
            o_lat, o_ctx = mixer_a(h_lat, h_ctx, a_w_qkv[j], a_q_gain[j], a_k_gain[j], a_w_o[j], need_ctx)
        elif kind == 1:
            o_lat, o_ctx = mixer_b(h_lat, h_ctx, b_w_qkv[j], b_sink[j], b_w_o[j], need_ctx)
        else:
            lam_init = 0.8 - 0.6 * math.exp(-0.3 * i)
            o_lat, o_ctx = mixer_c(h_lat, h_ctx, c_w_qkv[j], c_lam_q1[j], c_lam_k1[j], c_lam_q2[j], c_lam_k2[j],
                                   c_subln_gain[j], c_w_o[j], lam_init, need_ctx)
        xl = layer_norm(DEEPNORM_ALPHA * xl + g1 * o_lat, ln_gain[i, 0], ln_bias[i, 0])
        moe_args = (moe_w_group[i], moe_b_group[i], moe_w_expert[i], moe_b_expert[i],
                    moe_w_gate[i], moe_w_up[i], moe_w_down[i])
        if need_ctx:
            xc = layer_norm(DEEPNORM_ALPHA * xc + cg1 * o_ctx, ln_gain[i, 0], ln_bias[i, 0])
            h = jnp.concatenate([xc * (1.0 + csc2) + csh2, xl * (1.0 + sc2) + sh2], axis=1)
            f = hier_moe(h, *moe_args)
            f_ctx, f_lat = f[:, :n_ctx], f[:, n_ctx:]
            xc = layer_norm(DEEPNORM_ALPHA * xc + cg2 * f_ctx, ln_gain[i, 1], ln_bias[i, 1])
        else:
            f_lat = hier_moe(xl * (1.0 + sc2) + sh2, *moe_args)
        xl = layer_norm(DEEPNORM_ALPHA * xl + g2 * f_lat, ln_gain[i, 1], ln_bias[i, 1])
    return xl
```

```cpp
#include <hip/hip_runtime.h>
#include <hip/hip_bf16.h>
#include <cstdio>
#include <cstdint>

#ifndef MK_N_LAUNCHES
#define MK_N_LAUNCHES 1
#endif

#define LAS __attribute__((address_space(3)))
#define GAS __attribute__((address_space(1)))
typedef unsigned short bf16_t;
typedef short bf16x8 __attribute__((ext_vector_type(8)));
typedef short s16x4 __attribute__((ext_vector_type(4)));
typedef float f32x2 __attribute__((ext_vector_type(2)));
typedef float f32x4 __attribute__((ext_vector_type(4)));
typedef float f32x16 __attribute__((ext_vector_type(16)));
typedef unsigned u32x2 __attribute__((ext_vector_type(2)));
typedef unsigned u32x4 __attribute__((ext_vector_type(4)));

constexpr int DM = 1024, NB = 8, SEQ = 2048, CTXL = 256, TPB = SEQ + CTXL, MROWS = NB * TPB;
constexpr int DEPTH = 4, NEXP = 32, EFF = 512;
constexpr float ALPHA = 1.6817928305074292f;
constexpr float LN_EPS = 1e-5f, RMS_EPS = 1e-6f;
constexpr float LAM_INIT_C = 0.47071301834358416f;
constexpr int KSPLIT = 16;

constexpr size_t MiB = 1u << 20;
constexpr size_t WS_CTL = 0, CTL_ZERO_BYTES = 1 * MiB;
constexpr size_t WS_MOD = 1 * MiB;
constexpr size_t WS_ROPE = 2 * MiB;
constexpr size_t WS_WR = 2 * MiB + 64 * 1024;
constexpr size_t WS_PART = 3 * MiB;
constexpr size_t WS_TOK = 17 * MiB;
constexpr size_t WS_LIST = 18 * MiB;
constexpr size_t WS_WQKV = 21 * MiB;
constexpr size_t WS_WO = 36 * MiB;
constexpr size_t WS_WGU = 44 * MiB;
constexpr size_t WS_WD = 300 * MiB;
constexpr size_t WS_X = 428 * MiB;
constexpr size_t WS_Y = 500 * MiB;
constexpr size_t WS_HB = 572 * MiB;
constexpr size_t WS_QKV = 608 * MiB;
constexpr size_t WS_O = 716 * MiB;
constexpr size_t WS_HID = WS_QKV;
constexpr size_t WS_YS = 652 * MiB;
constexpr size_t WS_STASH = 752 * MiB;
constexpr size_t WS_END = 784 * MiB;
constexpr int MAXSLOT = 45056;
constexpr int CW_TMO = 0, CW_CODE = 1, CW_BAR = 4096, CW_CNT = 8192;

constexpr int MISC_OFF = 0;
constexpr int RING_OFF = 512, RING_BYTES = 131072;
constexpr int SS_OFF = RING_OFF + RING_BYTES;
constexpr int TAB_OFF = SS_OFF + 16384;
constexpr int LDS_BYTES = TAB_OFF + 1024;

#define RLX_AGENT __ATOMIC_RELAXED, __HIP_MEMORY_SCOPE_AGENT
template <class T> __device__ __forceinline__ T* opaque(T* p) { size_t z = 0; asm volatile("" : "+s"(z)); return (T*)((char*)p + z); }
__device__ __forceinline__ unsigned cvt_pk_bf16(float lo, float hi) { unsigned r; asm volatile("v_cvt_pk_bf16_f32 %0, %1, %2" : "=v"(r) : "v"(lo), "v"(hi)); return r; }
__device__ __forceinline__ float bf2f(unsigned short h) { return __uint_as_float(((unsigned)h) << 16); }
__device__ __forceinline__ float wave_sum(float v) {
#pragma unroll
    for (int o = 1; o < 64; o <<= 1) v += __shfl_xor(v, o);
    return v;
}

#define XB_TMO      128
#define XB_XCNT(j)  (256  + 64 * (j))
#define XB_XSUB(j)  (1280 + 64 * (j))
#define XB_XGEN(j)  (2304 + 64 * (j))
#define XB_TOP      3328
#define XB_TOPGEN   3392
#define XCD_BAR_WORDS 3456
#define XB_SPIN_CAP (1u << 18)
__device__ __forceinline__ unsigned xb_ld(unsigned* p)              { return __hip_atomic_load(p, __ATOMIC_RELAXED, __HIP_MEMORY_SCOPE_AGENT); }
__device__ __forceinline__ unsigned xb_add(unsigned* p, unsigned v) { return __hip_atomic_fetch_add(p, v, __ATOMIC_RELAXED, __HIP_MEMORY_SCOPE_AGENT); }
__device__ __forceinline__ unsigned xb_xcc_id() { return (unsigned)__builtin_amdgcn_s_getreg((3 << 11) | 20) & 0xFu; }
#define XB_SPIN(cond, bar) do { unsigned _sp = 0; while (cond) { __builtin_amdgcn_s_sleep(1); \
    if ((++_sp & 255u) == 0u) { if (xb_ld(&(bar)[XB_TMO])) break; if (_sp > XB_SPIN_CAP) { atomicAdd(&(bar)[XB_TMO], 1u); break; } } } } while (0)
struct XcdBarrier { unsigned* bar; unsigned x; volatile LAS unsigned* st; };
__device__ __forceinline__ XcdBarrier xcd_barrier_post(unsigned* bar, volatile LAS unsigned* st) {
    XcdBarrier b; b.bar = bar; b.x = xb_xcc_id(); b.st = st;
    if (threadIdx.x == 0) (void)xb_add(&bar[XB_XCNT(b.x)], 1u);
    return b;
}
__device__ __forceinline__ void xcd_barrier_complete(unsigned* bar, unsigned x, unsigned& nloc, unsigned& nx) {
    const unsigned G = gridDim.x * gridDim.y * gridDim.z;
    unsigned sum, cnt, mine, sp = 0u;
    for (;;) {
        sum = 0u; cnt = 0u; mine = 0u;
#pragma unroll
        for (unsigned j = 0; j < 16; ++j) { const unsigned c = xb_ld(&bar[XB_XCNT(j)]); sum += c; cnt += (c > 0u) ? 1u : 0u; mine = (j == x) ? c : mine; }
        if (sum == G) break;
        __builtin_amdgcn_s_sleep(1);
        if ((++sp & 255u) == 0u) { if (xb_ld(&bar[XB_TMO])) break; if (sp > XB_SPIN_CAP) { atomicAdd(&bar[XB_TMO], 1u); break; } }
    }
    nloc = mine > 0u ? mine : 1u; nx = cnt > 0u ? cnt : 1u;
}
__device__ __forceinline__ void xcd_barrier(const XcdBarrier& b) {
    asm volatile("s_waitcnt vmcnt(0)" ::: "memory");
    __syncthreads();
    if (threadIdx.x == 0) {
        unsigned* bar = b.bar;
        __builtin_amdgcn_s_waitcnt(0);
        unsigned nloc = b.st[0], nx = b.st[1];
        if (nloc == 0u) { xcd_barrier_complete(bar, b.x, nloc, nx); b.st[0] = nloc; b.st[1] = nx; }
        const unsigned old = xb_add(&bar[XB_XSUB(b.x)], 1u);
        const unsigned gen = old / nloc;
        if (old + 1u == (gen + 1u) * nloc) {
            __builtin_amdgcn_fence(__ATOMIC_RELEASE, "agent");
            asm volatile("s_waitcnt vmcnt(0)" ::: "memory");
            const unsigned og = xb_add(&bar[XB_TOP], 1u);
            const unsigned tg = og / nx;
            if (og + 1u == (tg + 1u) * nx) xb_add(&bar[XB_TOPGEN], 1u);
            else XB_SPIN(xb_ld(&bar[XB_TOPGEN]) == tg, bar);
            __builtin_amdgcn_fence(__ATOMIC_ACQUIRE, "agent");
            xb_add(&bar[XB_XGEN(b.x)], 1u);
            asm volatile("s_waitcnt vmcnt(0)" ::: "memory");
        } else {
            XB_SPIN(xb_ld(&bar[XB_XGEN(b.x)]) == gen, bar);
            __builtin_amdgcn_fence(__ATOMIC_ACQUIRE, "agent");
            asm volatile("s_waitcnt vmcnt(0)" ::: "memory");
        }
    }
    __syncthreads();
}

namespace pg8 {
constexpr int BM = 256, BK = 64, HALF = 128, HTB = HALF * BK * 2, STAGE_BYTES = 8 * HTB;
__device__ __forceinline__ int lds_byte(int r, int c) { const int st = (r >> 4) * 2 + (c >> 5), rr = r & 15, cc = c & 31, ob = rr * 64 + cc * 2; return st * 1024 + (ob ^ (((ob >> 9) & 1) << 5)); }
__device__ __forceinline__ void stage_rc(int b, int& R, int& C) { const int st = b / 1024, sb = b % 1024, swz = sb ^ (((sb >> 9) & 1) << 5); R = (st >> 1) * 16 + swz / 64; C = (st & 1) * 32 + (swz % 64) / 2; }
struct Unit { int pm, pn, e, nrow; };

template <class Epi, class Sched>
__device__ __forceinline__ void gemm_phase(LAS unsigned char* lds, const int K, const Sched& S, const Epi& E) {
    int tid = threadIdx.x; asm volatile("" : "+v"(tid));
    const int wid = __builtin_amdgcn_readfirstlane(tid >> 6), lane = tid & 63, wr = wid >> 2, wc = wid & 3, fr = lane & 15, fq = lane >> 4;
    const int nt = K / BK;
    unsigned voffB[2];
#pragma unroll
    for (int i = 0; i < 2; ++i) { int R_, C_; stage_rc(tid * 16 + i * 8192, R_, C_); voffB[i] = (unsigned)(R_ * K + C_) * 2u; }
    const size_t kstep = (size_t)(BK * 2);
    const size_t hstepB = (size_t)HALF * K * 2;
    const unsigned ldsw = (unsigned)wid * 1024u;
    const int aoff = lds_byte(wr * 64 + fr, fq * 8), boff = lds_byte(wc * 32 + fr, fq * 8);
#define PG8_SA(b, h) (((b) * 2 + (h)) * HTB)
#define PG8_SB(b, h) ((4 + (b) * 2 + (h)) * HTB)
#define PG8_STAGE(bufoff, gbase, voff) do { _Pragma("unroll") for (int _i = 0; _i < 2; ++_i) \
        __builtin_amdgcn_global_load_lds((const unsigned*)((const char*)(gbase) + (voff)[_i]), (LAS unsigned*)(lds + (bufoff) + ldsw + _i * 8192), 16, 0, 0); } while (0)
#define PG8_LDA(dst, b, h) do { _Pragma("unroll") for (int m = 0; m < 4; ++m) _Pragma("unroll") for (int k = 0; k < 2; ++k) dst[m][k] = *(const LAS bf16x8*)(lds + PG8_SA(b, h) + aoff + m * 2048 + k * 1024); } while (0)
#define PG8_LDB(dst, b, h) do { _Pragma("unroll") for (int n = 0; n < 2; ++n) _Pragma("unroll") for (int k = 0; k < 2; ++k) dst[n][k] = *(const LAS bf16x8*)(lds + PG8_SB(b, h) + boff + n * 2048 + k * 1024); } while (0)
#define PG8_MMA(ai, bj, At, Bt) do { __builtin_amdgcn_s_setprio(1); _Pragma("unroll") for (int m = 0; m < 4; ++m) _Pragma("unroll") for (int n = 0; n < 2; ++n) _Pragma("unroll") for (int k = 0; k < 2; ++k) \
        acc[ai][bj][m][n] = __builtin_amdgcn_mfma_f32_16x16x32_bf16(Bt[n][k], At[m][k], acc[ai][bj][m][n], 0, 0, 0); __builtin_amdgcn_s_setprio(0); } while (0)
#define PG8_WAIT_V(n) asm volatile("s_waitcnt vmcnt(" #n ")" ::: "memory")
#define PG8_WAIT_L(n) asm volatile("s_waitcnt lgkmcnt(" #n ")" ::: "memory")
#define PG8_BAR __builtin_amdgcn_s_barrier()
#define PG8_SCHED __builtin_amdgcn_sched_barrier(0)
    Unit cur, nxt; int ui = 0;
    if (!S.next(0, cur)) return;
    f32x4 acc[2][2][4][2];
#pragma unroll
    for (int a = 0; a < 2; ++a)
#pragma unroll
        for (int b = 0; b < 2; ++b)
#pragma unroll
            for (int m = 0; m < 4; ++m)
#pragma unroll
                for (int n = 0; n < 2; ++n) acc[a][b][m][n] = (f32x4){0.f, 0.f, 0.f, 0.f};
    bf16x8 At[4][2], B0[2][2], B1[2][2];
    unsigned vA0[2], vA1[2], nA0[2], nA1[2];
    S.a_voff(cur, tid, K, vA0, vA1);
    const char* cA = S.a_ptr(cur); const char* cB = S.b_ptr(cur);
    PG8_STAGE(PG8_SB(0, 0), cB, voffB); PG8_STAGE(PG8_SB(0, 1), cB + hstepB, voffB); PG8_STAGE(PG8_SA(0, 0), cA, vA0); PG8_STAGE(PG8_SA(0, 1), cA, vA1);
    if (wr == 1) PG8_BAR;
    PG8_WAIT_V(2); PG8_BAR;
    PG8_STAGE(PG8_SB(1, 0), cB + kstep, voffB); PG8_STAGE(PG8_SA(1, 0), cA + kstep, vA0); PG8_STAGE(PG8_SB(1, 1), cB + hstepB + kstep, voffB);
    PG8_WAIT_V(6); PG8_BAR;
    for (;;) {
        const bool has_next = S.next(ui + 1, nxt);
        const char* nA = cA; const char* nB = cB;
#pragma unroll
        for (int i = 0; i < 2; ++i) { nA0[i] = vA0[i]; nA1[i] = vA1[i]; }
        if (has_next) { nA = S.a_ptr(nxt); nB = S.b_ptr(nxt); S.a_voff(nxt, tid, K, nA0, nA1); }
        for (int t = 0; t < nt; t += 2) {
            const bool last = (t == nt - 2);
            const char* a1 = cA + (size_t)(t + 1) * kstep;
            const char* a2 = last ? nA : cA + (size_t)(t + 2) * kstep; const char* b2 = last ? nB : cB + (size_t)(t + 2) * kstep;
            const char* a3 = a2 + kstep; const char* b3 = b2 + kstep;
            PG8_LDB(B0, 0, 0); PG8_LDB(B1, 0, 1); PG8_SCHED; PG8_LDA(At, 0, 0); PG8_STAGE(PG8_SA(1, 1), a1, vA1);
            if (last) {
#pragma unroll
                for (int i = 0; i < 2; ++i) { vA0[i] = nA0[i]; vA1[i] = nA1[i]; } }
            PG8_WAIT_V(8); PG8_WAIT_L(0); PG8_BAR; PG8_MMA(0, 0, At, B0); PG8_MMA(0, 1, At, B1); PG8_BAR; PG8_SCHED;
            PG8_LDA(At, 0, 1); PG8_STAGE(PG8_SB(0, 0), b2, voffB); PG8_STAGE(PG8_SB(0, 1), b2 + hstepB, voffB); PG8_STAGE(PG8_SA(0, 0), a2, vA0);
            PG8_WAIT_V(8); PG8_WAIT_L(0); PG8_BAR; PG8_MMA(1, 0, At, B0); PG8_MMA(1, 1, At, B1); PG8_BAR; PG8_SCHED;
            PG8_LDB(B0, 1, 0); PG8_LDB(B1, 1, 1); PG8_SCHED; PG8_LDA(At, 1, 0); PG8_STAGE(PG8_SA(0, 1), a2, vA1);
            PG8_WAIT_V(8); PG8_WAIT_L(0); PG8_BAR; PG8_MMA(0, 0, At, B0); PG8_MMA(0, 1, At, B1); PG8_BAR; PG8_SCHED;
            PG8_LDA(At, 1, 1); PG8_STAGE(PG8_SB(1, 0), b3, voffB); PG8_STAGE(PG8_SB(1, 1), b3 + hstepB, voffB); PG8_STAGE(PG8_SA(1, 0), a3, vA0);
            PG8_WAIT_V(8); PG8_WAIT_L(0); PG8_BAR; PG8_MMA(1, 0, At, B0); PG8_MMA(1, 1, At, B1); PG8_BAR; PG8_SCHED;
        }
        if (wr == 0) PG8_BAR;
        E(acc, cur, ui, wr, wc, fr, fq);
        if (!has_next) break;
#pragma unroll
        for (int a = 0; a < 2; ++a)
#pragma unroll
            for (int b = 0; b < 2; ++b)
#pragma unroll
                for (int m = 0; m < 4; ++m)
#pragma unroll
                    for (int n = 0; n < 2; ++n) acc[a][b][m][n] = (f32x4){0.f, 0.f, 0.f, 0.f};
        cur = nxt; cA = nA; cB = nB; ++ui;
        if (wr == 1) PG8_BAR;
    }
    PG8_WAIT_V(0);
    PG8_BAR;
#undef PG8_SA
#undef PG8_SB
#undef PG8_STAGE
#undef PG8_LDA
#undef PG8_LDB
#undef PG8_MMA
#undef PG8_WAIT_V
#undef PG8_WAIT_L
#undef PG8_BAR
#undef PG8_SCHED
}
}

struct DenseSched {
    const char* A; const char* Bt; int K, nM, nN, nwg, G, c, latonly;
    __device__ __forceinline__ void init(const void* A_, const void* Bt_, int K_, int nM_, int nN_, int G_, int c_, int latonly_) { A = (const char*)A_; Bt = (const char*)Bt_; K = K_; nM = nM_; nN = nN_; nwg = nM * nN; G = G_; c = c_; latonly = latonly_; }
    __device__ __forceinline__ bool next(int i, pg8::Unit& u) const {
        const long L = (long)i * G + c; if (L >= nwg) return false;
        int wgid = (int)L; { const int q = nwg / 8, r = nwg % 8, xcd = wgid % 8, off = wgid / 8; wgid = (xcd < r ? xcd * (q + 1) : r * (q + 1) + (xcd - r) * q) + off; }
        const int nig = 8 * nN, gid = wgid / nig, fm = gid * 8, gsz = (nM - fm) < 8 ? (nM - fm) : 8;
        int pm = fm + ((wgid % nig) % gsz); u.pn = (wgid % nig) / gsz;
        if (latonly) pm = (pm >> 3) * 9 + (pm & 7);
        u.pm = pm; u.e = 0; u.nrow = 0; return true;
    }
    __device__ __forceinline__ const char* a_ptr(const pg8::Unit& u) const { return A + (size_t)u.pm * 256 * K * 2; }
    __device__ __forceinline__ const char* b_ptr(const pg8::Unit& u) const { return Bt + (size_t)u.pn * 256 * K * 2; }
    __device__ __forceinline__ void a_voff(const pg8::Unit&, int tid, int K_, unsigned (&v0)[2], unsigned (&v1)[2]) const {
#pragma unroll
        for (int i = 0; i < 2; ++i) { int R, C; pg8::stage_rc(tid * 16 + i * 8192, R, C); v0[i] = (unsigned)(R * K_ + C) * 2u; v1[i] = (unsigned)((128 + R) * K_ + C) * 2u; }
    }
};
__device__ __forceinline__ int moe_find(const LAS int* tab, int mt) { int e = 0;
#pragma unroll 1
    for (int j = 1; j < 32; ++j) e = (tab[32 + j] <= mt) ? j : e;
    return e; }
struct MoeGuSched {
    const char* HB; const char* W; const int* list; const LAS int* tab; int G, c;
    __device__ __forceinline__ bool next(int i, pg8::Unit& u) const {
        const int L = i * G + c, T = tab[64]; if (L >= 4 * T) return false;
        const int mt = L >> 2; u.pm = mt; u.pn = L & 3; const int e = moe_find(tab, mt); u.e = e; u.nrow = mt - tab[32 + e]; return true;
    }
    __device__ __forceinline__ const char* a_ptr(const pg8::Unit&) const { return HB; }
    __device__ __forceinline__ const char* b_ptr(const pg8::Unit& u) const { return W + ((size_t)u.e * 1024 + (size_t)u.pn * 256) * 1024 * 2; }
    __device__ __forceinline__ void a_voff(const pg8::Unit& u, int tid, int K_, unsigned (&v0)[2], unsigned (&v1)[2]) const {
        const int n = tab[u.e]; const int* lp = list + (size_t)u.e * MROWS;
#pragma unroll
        for (int i = 0; i < 2; ++i) { int R, C; pg8::stage_rc(tid * 16 + i * 8192, R, C);
            int i0 = u.nrow * 256 + R, i1 = i0 + 128; i0 = i0 < n ? i0 : n - 1; i1 = i1 < n ? i1 : n - 1;
            const int t0 = lp[i0], t1 = lp[i1];
            v0[i] = (unsigned)(t0 * K_ + C) * 2u; v1[i] = (unsigned)(t1 * K_ + C) * 2u; }
    }
};
struct MoeDownSched {
    const char* HID; const char* W; const LAS int* tab; int G, c;
    __device__ __forceinline__ bool next(int i, pg8::Unit& u) const {
        const int L = i * G + c, T = tab[64]; if (L >= 4 * T) return false;
        const int mt = L >> 2; u.pm = mt; u.pn = L & 3; u.e = moe_find(tab, mt); u.nrow = 0; return true;
    }
    __device__ __forceinline__ const char* a_ptr(const pg8::Unit& u) const { return HID + (size_t)u.pm * 256 * EFF * 2; }
    __device__ __forceinline__ const char* b_ptr(const pg8::Unit& u) const { return W + ((size_t)u.e * 1024 + (size_t)u.pn * 256) * EFF * 2; }
    __device__ __forceinline__ void a_voff(const pg8::Unit&, int tid, int K_, unsigned (&v0)[2], unsigned (&v1)[2]) const {
#pragma unroll
        for (int i = 0; i < 2; ++i) { int R, C; pg8::stage_rc(tid * 16 + i * 8192, R, C); v0[i] = (unsigned)(R * K_ + C) * 2u; v1[i] = (unsigned)((128 + R) * K_ + C) * 2u; }
    }
};

template <int KIND> struct EpiQKV {
    bf16_t* out; int ldo; const float* rope; const float* qg; const float* kg; LAS float* ss;
    __device__ __forceinline__ void operator()(f32x4 (&acc)[2][2][4][2], const pg8::Unit& u, int ui, int wr, int wc, int fr, int fq) const {
        const int pmod = u.pm % 9; const bool is_ctx = (pmod == 8); const int tb = pmod * 256;
        constexpr int nrope = (KIND == 2) ? 8 : 5;
        const bool isqk = u.pn < nrope, do_rope = isqk && !is_ctx;
        constexpr int NF = (KIND == 0) ? 32 : 16;
        const int axis = (KIND == 0) ? (wc >> 1) : (wc & 1), f0 = (KIND == 0) ? ((wc & 1) * 16 + 4 * fq) : 4 * fq;
        LAS float* S = ss + (ui & 1) * 2048;
        f32x4 g0 = (f32x4){1.f, 1.f, 1.f, 1.f}, g1 = g0;
        if constexpr (KIND == 0) {
#pragma unroll
            for (int ai = 0; ai < 2; ++ai)
#pragma unroll
                for (int m = 0; m < 4; ++m)
#pragma unroll
                    for (int bj = 0; bj < 2; ++bj) {
                        const f32x4 a = acc[ai][bj][m][0], b = acc[ai][bj][m][1];
                        float s = (a[0] * a[0] + a[1] * a[1]) + (a[2] * a[2] + a[3] * a[3]) + (b[0] * b[0] + b[1] * b[1]) + (b[2] * b[2] + b[3] * b[3]);
                        s += __shfl_xor(s, 16); s += __shfl_xor(s, 32);
                        if (fq == 0) S[(ai * 128 + wr * 64 + m * 16 + fr) * 8 + bj * 4 + wc] = s;
                    }
            asm volatile("s_waitcnt lgkmcnt(0)" ::: "memory"); __builtin_amdgcn_s_barrier(); asm volatile("" ::: "memory");
            if (isqk) { const float* gain = (u.pn < 4) ? qg : kg; g0 = *(const f32x4*)(gain + axis * 64 + f0); g1 = *(const f32x4*)(gain + axis * 64 + 32 + f0); }
        }
#pragma unroll
        for (int ai = 0; ai < 2; ++ai)
#pragma unroll
            for (int m = 0; m < 4; ++m) {
                const int rt = ai * 128 + wr * 64 + m * 16 + fr, t = tb + rt, pos = axis ? (t & 63) : (t >> 6);
                f32x4 cs = (f32x4){1.f, 1.f, 1.f, 1.f}, sn = (f32x4){0.f, 0.f, 0.f, 0.f};
                if (do_rope) { cs = *(const f32x4*)(rope + pos * NF + f0); sn = *(const f32x4*)(rope + 64 * NF + pos * NF + f0); }
                bf16_t* rowp = out + (size_t)(u.pm * 256 + rt) * ldo + u.pn * 256 + wc * 32 + 4 * fq;
#pragma unroll
                for (int bj = 0; bj < 2; ++bj) {
                    f32x4 x1 = acc[ai][bj][m][0], x2 = acc[ai][bj][m][1];
                    if constexpr (KIND == 0) { if (isqk) {
                        const f32x4 pp = *(const LAS f32x4*)(S + rt * 8 + bj * 4);
                        const float r = 1.0f / sqrtf(((pp[0] + pp[1]) + (pp[2] + pp[3])) * (1.0f / 128.0f) + RMS_EPS);
                        x1 = x1 * r * g0; x2 = x2 * r * g1; } }
                    const f32x4 o1 = x1 * cs - x2 * sn, o2 = x1 * sn + x2 * cs;
                    u32x2 w; w.x = cvt_pk_bf16(o1[0], o1[1]); w.y = cvt_pk_bf16(o1[2], o1[3]); *(u32x2*)(rowp + bj * 128) = w;
                    w.x = cvt_pk_bf16(o2[0], o2[1]); w.y = cvt_pk_bf16(o2[2], o2[3]); *(u32x2*)(rowp + bj * 128 + 16) = w;
                }
                asm volatile("" ::: "memory");
            }
    }
};
struct EpiWo {
    const float* X; float* Y; const float* mod;
    __device__ __forceinline__ void operator()(f32x4 (&acc)[2][2][4][2], const pg8::Unit& u, int, int wr, int wc, int fr, int fq) const {
        const int bb = (u.pm % 9 == 8) ? 8 : u.pm / 9; const float* g1 = mod + bb * 6144 + 2048;
        const int col0 = u.pn * 256 + wc * 32 + 4 * fq;
        f32x4 gv[2][2];
#pragma unroll
        for (int bj = 0; bj < 2; ++bj)
#pragma unroll
            for (int n = 0; n < 2; ++n) gv[bj][n] = *(const f32x4*)(g1 + col0 + bj * 128 + n * 16);
#pragma unroll
        for (int ai = 0; ai < 2; ++ai)
#pragma unroll
            for (int m = 0; m < 4; ++m) { const size_t off = (size_t)(u.pm * 256 + ai * 128 + wr * 64 + m * 16 + fr) * DM + col0;
#pragma unroll
                for (int bj = 0; bj < 2; ++bj)
#pragma unroll
                    for (int n = 0; n < 2; ++n) { const f32x4 xv = *(const f32x4*)(X + off + bj * 128 + n * 16); *(f32x4*)(Y + off + bj * 128 + n * 16) = xv * ALPHA + gv[bj][n] * acc[ai][bj][m][n]; }
                if (m & 1) asm volatile("" ::: "memory"); }
    }
};
struct EpiGU {
    bf16_t* HID;
    __device__ __forceinline__ void operator()(f32x4 (&acc)[2][2][4][2], const pg8::Unit& u, int, int wr, int wc, int fr, int fq) const {
#pragma unroll
        for (int ai = 0; ai < 2; ++ai)
#pragma unroll
            for (int m = 0; m < 4; ++m) { bf16_t* rowp = HID + (size_t)(u.pm * 256 + ai * 128 + wr * 64 + m * 16 + fr) * EFF + u.pn * 128 + wc * 32 + 4 * fq;
#pragma unroll
                for (int n = 0; n < 2; ++n) { const f32x4 a = acc[ai][0][m][n], b = acc[ai][1][m][n]; f32x4 h;
#pragma unroll
                    for (int j = 0; j < 4; ++j) h[j] = a[j] * __builtin_amdgcn_rcpf(1.0f + __expf(-a[j])) * b[j];
                    u32x2 w; w.x = cvt_pk_bf16(h[0], h[1]); w.y = cvt_pk_bf16(h[2], h[3]); *(u32x2*)(rowp + n * 16) = w; } }
    }
};
struct EpiDown {
    bf16_t* YS;
    __device__ __forceinline__ void operator()(f32x4 (&acc)[2][2][4][2], const pg8::Unit& u, int, int wr, int wc, int fr, int fq) const {
#pragma unroll
        for (int ai = 0; ai < 2; ++ai)
#pragma unroll
            for (int m = 0; m < 4; ++m) { bf16_t* rowp = YS + (size_t)(u.pm * 256 + ai * 128 + wr * 64 + m * 16 + fr) * DM + u.pn * 256 + wc * 32 + 4 * fq;
#pragma unroll
                for (int bj = 0; bj < 2; ++bj)
#pragma unroll
                    for (int n = 0; n < 2; ++n) { const f32x4 v = acc[ai][bj][m][n]; u32x2 w; w.x = cvt_pk_bf16(v[0], v[1]); w.y = cvt_pk_bf16(v[2], v[3]); *(u32x2*)(rowp + bj * 128 + n * 16) = w; } }
    }
};

namespace att {
#define SBAR() __builtin_amdgcn_sched_barrier(0)
__device__ __forceinline__ int crow(int r, int hi) { return (r & 3) + 8 * (r >> 2) + 4 * hi; }
template <int DQK> __device__ __forceinline__ int kswz(int row, int colB) { return row * (DQK * 2) + (colB ^ ((row & 7) << 4)); }
template <int NCB> __device__ __forceinline__ int v_st(int k, int c) { const int kk = (k & ~0xC) | ((k & 4) << 1) | ((k & 8) >> 1); return ((kk >> 3) * NCB + (c >> 5)) * 512 + ((kk & 7) * 32 + (c & 31)) * 2; }
__device__ __forceinline__ int v_rd_base(int lane) { return ((lane & 3) << 3) | (((lane >> 2) & 3) << 6) | (((lane >> 4) & 1) << 5) | (((lane >> 5) & 1) << 8); }
template <int NCB> constexpr int v_rd_off(int d0, int ks, int half) { return d0 * 512 + ks * (2 * NCB * 512) + half * (NCB * 512); }
template <int OFF> __device__ __forceinline__ s16x4 tr_read(int vb) { s16x4 r; asm volatile("ds_read_b64_tr_b16 %0, %1 offset:%2" : "=&v"(r) : "v"(vb), "i"(OFF) : "memory"); return r; }

template <int DQK> __device__ __forceinline__ void partialSM(f32x16& p0, f32x16& p1, float& m_reg, float& mn, float& alpha) {
    constexpr float SCALE = (DQK == 128) ? 0.088388347648318440f : 0.125f, C = SCALE * 1.4426950408889634f, THRS = 8.f / SCALE;
    float pmax = p0[0];
#pragma unroll
    for (int r = 1; r < 16; ++r) pmax = fmaxf(pmax, p0[r]);
#pragma unroll
    for (int r = 0; r < 16; ++r) pmax = fmaxf(pmax, p1[r]);
    { auto rr = __builtin_amdgcn_permlane32_swap(__float_as_uint(pmax), __float_as_uint(pmax), false, false); pmax = fmaxf(__uint_as_float(rr[0]), __uint_as_float(rr[1])); }
    if (__builtin_expect(__all(pmax - m_reg <= THRS), 1)) { mn = m_reg; alpha = 1.f; }
    else { mn = fmaxf(m_reg, pmax); alpha = __builtin_amdgcn_exp2f((m_reg - mn) * C); m_reg = mn; }
    const float mnC = -mn * C;
#pragma unroll
    for (int r = 0; r < 16; ++r) p0[r] = fmaf(p0[r], C, mnC);
#pragma unroll
    for (int r = 0; r < 16; ++r) p1[r] = fmaf(p1[r], C, mnC);
#pragma unroll
    for (int r = 0; r < 16; ++r) p0[r] = __builtin_amdgcn_exp2f(p0[r]);
}
__device__ __forceinline__ void finishSM(f32x16& p0, f32x16& p1, float alpha, float& l_reg, bf16x8& pa0, bf16x8& pa1, bf16x8& pa2, bf16x8& pa3) {
#pragma unroll
    for (int r = 0; r < 16; ++r) p1[r] = __builtin_amdgcn_exp2f(p1[r]);
    float ps = 0;
#pragma unroll
    for (int r = 0; r < 16; ++r) ps += p0[r];
#pragma unroll
    for (int r = 0; r < 16; ++r) ps += p1[r];
    { auto rr = __builtin_amdgcn_permlane32_swap(__float_as_uint(ps), __float_as_uint(ps), false, false); ps = __uint_as_float(rr[0]) + __uint_as_float(rr[1]); }
    l_reg = l_reg * alpha + ps;
#define PK4(P, BASE, OUT) do { unsigned a0 = cvt_pk_bf16(P[BASE + 0], P[BASE + 1]), a1 = cvt_pk_bf16(P[BASE + 2], P[BASE + 3]);   \
    unsigned b0 = cvt_pk_bf16(P[BASE + 4], P[BASE + 5]), b1 = cvt_pk_bf16(P[BASE + 6], P[BASE + 7]);                              \
    auto r0 = __builtin_amdgcn_permlane32_swap(a0, b0, false, false); auto r1 = __builtin_amdgcn_permlane32_swap(a1, b1, false, false); \
    u32x4 w = {r0[0], r1[0], r0[1], r1[1]}; OUT = __builtin_bit_cast(bf16x8, w); } while (0)
    PK4(p0, 0, pa0); PK4(p0, 8, pa1); PK4(p1, 0, pa2); PK4(p1, 8, pa3);
#undef PK4
}
template <int DQK> __device__ __forceinline__ void qkt(f32x16& p0, f32x16& p1, const LAS char* Ks, const bf16x8* qr, int r32, int hi) {
    p0 = f32x16{}; p1 = f32x16{};
#pragma unroll
    for (int d0 = 0; d0 < DQK / 16; ++d0) { const int cb = (d0 * 16 + hi * 8) * 2;
        const bf16x8 b0 = *(const LAS bf16x8*)(Ks + kswz<DQK>(r32, cb));
        const bf16x8 b1 = *(const LAS bf16x8*)(Ks + kswz<DQK>(32 + r32, cb));
        p0 = __builtin_amdgcn_mfma_f32_32x32x16_bf16(b0, qr[d0], p0, 0, 0, 0);
        p1 = __builtin_amdgcn_mfma_f32_32x32x16_bf16(b1, qr[d0], p1, 0, 0, 0); }
}
template <int NCB, int D0> __device__ __forceinline__ void pv_one(f32x16& od, int vb, bf16x8 pa0, bf16x8 pa1, bf16x8 pa2, bf16x8 pa3) {
    const s16x4 l0 = tr_read<v_rd_off<NCB>(D0, 0, 0)>(vb), h0 = tr_read<v_rd_off<NCB>(D0, 0, 1)>(vb), l1 = tr_read<v_rd_off<NCB>(D0, 1, 0)>(vb), h1 = tr_read<v_rd_off<NCB>(D0, 1, 1)>(vb);
    const s16x4 l2 = tr_read<v_rd_off<NCB>(D0, 2, 0)>(vb), h2 = tr_read<v_rd_off<NCB>(D0, 2, 1)>(vb), l3 = tr_read<v_rd_off<NCB>(D0, 3, 0)>(vb), h3 = tr_read<v_rd_off<NCB>(D0, 3, 1)>(vb);
    asm volatile("s_waitcnt lgkmcnt(0)" ::: "memory"); SBAR();
#define PK(L, H) (bf16x8){L[0], L[1], L[2], L[3], H[0], H[1], H[2], H[3]}
    od = __builtin_amdgcn_mfma_f32_32x32x16_bf16(pa0, PK(l0, h0), od, 0, 0, 0);
    od = __builtin_amdgcn_mfma_f32_32x32x16_bf16(pa1, PK(l1, h1), od, 0, 0, 0);
    od = __builtin_amdgcn_mfma_f32_32x32x16_bf16(pa2, PK(l2, h2), od, 0, 0, 0);
    od = __builtin_amdgcn_mfma_f32_32x32x16_bf16(pa3, PK(l3, h3), od, 0, 0, 0);
#undef PK
}
template <int DV> __device__ __forceinline__ void pv_all(f32x16 (&o)[DV / 32], int vb, bf16x8 pa0, bf16x8 pa1, bf16x8 pa2, bf16x8 pa3) {
    constexpr int NCB = DV / 32;
    pv_one<NCB, 0>(o[0], vb, pa0, pa1, pa2, pa3); pv_one<NCB, 1>(o[1], vb, pa0, pa1, pa2, pa3);
    if constexpr (DV == 128) { pv_one<NCB, 2>(o[2], vb, pa0, pa1, pa2, pa3); pv_one<NCB, 3>(o[3], vb, pa0, pa1, pa2, pa3); }
}

template <int DQK, int DV, bool WIN>
__device__ __forceinline__ void attn_core(const bf16_t* __restrict__ Qb, const int ldq, const bf16_t* __restrict__ Kh, const bf16_t* __restrict__ Vh, const int ldk,
                                          const int NT, const int nfirst, const int base1, const int base2, const int qpos0,
                                          LAS char* lds, f32x16 (&o)[DV / 32], float& m_out, float& l_out) {
    constexpr int SHM_V = 64 * DV * 2, SHM_K = 64 * DQK * 2, KP = DQK / 64, VP = DV / 64, NCB = DV / 32, ND = DQK / 16;
    int tid = threadIdx.x; asm volatile("" : "+v"(tid));
    const int wid = tid >> 6, lane = tid & 63, r32 = lane & 31, hi = lane >> 5;
    LAS char* V_lds = lds; LAS char* K_lds = lds + 2 * SHM_V;
    LAS float* ws = (LAS float*)(lds + 2 * SHM_V + 2 * SHM_K) + wid * 64; LAS float* al_l = ws + 32;
    float m_reg = -1e30f, l_reg = 0.f;
#pragma unroll
    for (int d = 0; d < DV / 32; ++d) o[d] = f32x16{};
    bf16x8 qr[ND];
    const bf16_t* Qw = Qb + (size_t)(wid * 32 + r32) * ldq + hi * 8;
#pragma unroll
    for (int d0 = 0; d0 < ND; ++d0) qr[d0] = *(const bf16x8*)(Qw + d0 * 16);
    const int ksr = (KP == 2) ? (tid >> 4) : (tid >> 3), ksc = (KP == 2) ? (tid & 15) * 8 : (tid & 7) * 8;
    const int vsr = (VP == 2) ? (tid >> 4) : (tid >> 3), vsc = (VP == 2) ? (tid & 15) * 8 : (tid & 7) * 8;
    const int kst0 = kswz<DQK>(ksr, ksc * 2), kst1 = kswz<DQK>(32 + ksr, ksc * 2), vst0 = v_st<NCB>(vsr, vsc), vst1 = v_st<NCB>(32 + vsr, vsc);
    const int vb0 = (int)(unsigned)(uintptr_t)V_lds + v_rd_base(lane);
    struct { bf16x8 vs0, vs1, ks0, ks1; } sr_[2];
#define KB(j) (((j) < nfirst) ? base1 + 64 * (j) : base2 + 64 * ((j) - nfirst))
#define SLOAD(i, j) do { const int kb_ = KB(j); sr_[i].ks0 = *(const bf16x8*)(&Kh[(size_t)(kb_ + ksr) * ldk + ksc]); if (KP == 2) sr_[i].ks1 = *(const bf16x8*)(&Kh[(size_t)(kb_ + 32 + ksr) * ldk + ksc]); \
    sr_[i].vs0 = *(const bf16x8*)(&Vh[(size_t)(kb_ + vsr) * ldk + vsc]); if (VP == 2) sr_[i].vs1 = *(const bf16x8*)(&Vh[(size_t)(kb_ + 32 + vsr) * ldk + vsc]); } while (0)
#define SWRITE(b, i) do { *(LAS bf16x8*)(V_lds + (b) * SHM_V + vst0) = sr_[i].vs0; if (VP == 2) *(LAS bf16x8*)(V_lds + (b) * SHM_V + vst1) = sr_[i].vs1; \
    *(LAS bf16x8*)(K_lds + (b) * SHM_K + kst0) = sr_[i].ks0; if (KP == 2) *(LAS bf16x8*)(K_lds + (b) * SHM_K + kst1) = sr_[i].ks1; } while (0)
#define RESC(a) do { if (__any((a) < 1.f)) { if (hi == 0) al_l[r32] = (a); asm volatile("s_waitcnt lgkmcnt(0)" ::: "memory"); \
    _Pragma("unroll") for (int d = 0; d < DV / 32; ++d) _Pragma("unroll") for (int r = 0; r < 16; ++r) o[d][r] *= al_l[crow(r, hi)]; } } while (0)
#define MASK(P0, P1, j) do { if (WIN && (j) >= nfirst) { const int dq_ = base2 + 64 * ((j) - nfirst) - (qpos0 + wid * 32 + r32); \
    _Pragma("unroll") for (int r = 0; r < 16; ++r) { const int dd_ = dq_ + crow(r, hi); if ((unsigned)(dd_ + 128) > 256u) P0[r] = -1e30f; if ((unsigned)(dd_ + 160) > 256u) P1[r] = -1e30f; } } } while (0)
    f32x16 pA0, pA1, pB0, pB1; float mnA, mnB, alA, alB; bf16x8 pa0, pa1, pa2, pa3;
    SLOAD(0, 0); asm volatile("s_waitcnt vmcnt(0)" ::: "memory"); SWRITE(0, 0); __syncthreads();
    qkt<DQK>(pA0, pA1, K_lds, qr, r32, hi); MASK(pA0, pA1, 0); partialSM<DQK>(pA0, pA1, m_reg, mnA, alA);
    SLOAD(1, 1); if (2 < NT) SLOAD(0, 2);
    SWRITE(1, 1); __syncthreads();
    for (int j = 1; j + 1 < NT; j += 2) {
        SBAR(); qkt<DQK>(pB0, pB1, K_lds + SHM_K, qr, r32, hi); MASK(pB0, pB1, j);
        finishSM(pA0, pA1, alA, l_reg, pa0, pa1, pa2, pa3); SBAR();
        SLOAD(1, j + 2); SBAR();
        pv_all<DV>(o, vb0, pa0, pa1, pa2, pa3); partialSM<DQK>(pB0, pB1, m_reg, mnB, alB);
        __syncthreads(); SWRITE(0, 0);
        RESC(alB); __syncthreads();
        SBAR(); qkt<DQK>(pA0, pA1, K_lds, qr, r32, hi); MASK(pA0, pA1, j + 1);
        finishSM(pB0, pB1, alB, l_reg, pa0, pa1, pa2, pa3); SBAR();
        if (j + 3 < NT) SLOAD(0, j + 3); SBAR();
        pv_all<DV>(o, vb0 + SHM_V, pa0, pa1, pa2, pa3); partialSM<DQK>(pA0, pA1, m_reg, mnA, alA);
        __syncthreads(); SWRITE(1, 1);
        RESC(alA); __syncthreads();
    }
    SBAR(); qkt<DQK>(pB0, pB1, K_lds + SHM_K, qr, r32, hi); MASK(pB0, pB1, NT - 1);
    finishSM(pA0, pA1, alA, l_reg, pa0, pa1, pa2, pa3); SBAR();
    pv_all<DV>(o, vb0, pa0, pa1, pa2, pa3); partialSM<DQK>(pB0, pB1, m_reg, mnB, alB);
    __syncthreads(); RESC(alB);
    finishSM(pB0, pB1, alB, l_reg, pa0, pa1, pa2, pa3); SBAR();
    pv_all<DV>(o, vb0 + SHM_V, pa0, pa1, pa2, pa3);
    m_out = m_reg; l_out = l_reg;
#undef KB
#undef SLOAD
#undef SWRITE
#undef RESC
#undef MASK
}
__device__ __forceinline__ void row_bcast(LAS float* ws, float v, int r32, int hi, float (&out)[16]) {
    if (hi == 0) ws[r32] = v; asm volatile("s_waitcnt lgkmcnt(0)" ::: "memory");
#pragma unroll
    for (int r = 0; r < 16; ++r) out[r] = ws[crow(r, hi)];
    asm volatile("s_waitcnt lgkmcnt(0)" ::: "memory");
}
#undef SBAR
}

constexpr int NPHASE = 3 + 7 * DEPTH;
struct Args { const float* in[29]; float* out; unsigned char* ws; int ph_lo, ph_hi; };

__device__ __forceinline__ void sincos_small(double x, double& s, double& c) {
    const double k = __builtin_rint(x * 0.6366197723675814);
    const double r = (x - k * 1.5707963267341256) - k * 6.077100506506192e-11;
    const double r2 = r * r;
    double sp = 1.0 / 6402373705728000.0, cp = 1.0 / 355687428096000.0;
    double cs = -sp; cs = cs * r2 + 1.0 / 20922789888000.0; cs = cs * r2 - 1.0 / 87178291200.0; cs = cs * r2 + 1.0 / 479001600.0; cs = cs * r2 - 1.0 / 3628800.0;
    cs = cs * r2 + 1.0 / 40320.0; cs = cs * r2 - 1.0 / 720.0; cs = cs * r2 + 1.0 / 24.0; cs = cs * r2 - 0.5; cs = cs * r2 + 1.0;
    double sn = cp; sn = sn * r2 - 1.0 / 1307674368000.0; sn = sn * r2 + 1.0 / 6227020800.0; sn = sn * r2 - 1.0 / 39916800.0; sn = sn * r2 + 1.0 / 362880.0;
    sn = sn * r2 - 1.0 / 5040.0; sn = sn * r2 + 1.0 / 120.0; sn = sn * r2 - 1.0 / 6.0; sn = sn * r2 + 1.0; sn = sn * r;
    const int q = ((int)k) & 3;
    s = (q == 0) ? sn : (q == 1) ? cs : (q == 2) ? -sn : -cs;
    c = (q == 0) ? cs : (q == 1) ? -sn : (q == 2) ? -cs : sn;
}

__device__ __forceinline__ void transpose_tile(const float* __restrict__ src, int N, int k0, int n0, bf16_t* __restrict__ dst, int ldk, int drow0, bool perm, LAS float* scr, int lane) {
    const int rsub = lane >> 4, c4 = (lane & 15) * 4;
    f32x4 v[16];
#pragma unroll
    for (int i = 0; i < 16; ++i) v[i] = *(const f32x4*)(src + (size_t)(k0 + 4 * i + rsub) * N + n0 + c4);
#pragma unroll
    for (int i = 0; i < 16; ++i) { LAS float* p = scr + (4 * i + rsub) * 65 + c4; p[0] = v[i][0]; p[1] = v[i][1]; p[2] = v[i][2]; p[3] = v[i][3]; }
    asm volatile("s_waitcnt lgkmcnt(0)" ::: "memory");
    const int c = lane & 7, nl = lane >> 3;
#pragma unroll
    for (int j = 0; j < 8; ++j) { const int n = nl + 8 * j; const LAS float* s = scr + (8 * c) * 65 + n;
        u32x4 o; o.x = cvt_pk_bf16(s[0], s[65]); o.y = cvt_pk_bf16(s[2 * 65], s[3 * 65]); o.z = cvt_pk_bf16(s[4 * 65], s[5 * 65]); o.w = cvt_pk_bf16(s[6 * 65], s[7 * 65]);
        const int nn = perm ? ((n & 15) | ((n & 16) << 1) | ((n & 32) >> 1)) : n;
        *(u32x4*)(dst + (size_t)(drow0 + nn) * ldk + k0 + 8 * c) = o; }
    asm volatile("s_waitcnt lgkmcnt(0)" ::: "memory");
}

__global__ void __launch_bounds__(512, 2) fwd(Args args) {
    extern __shared__ __attribute__((aligned(16))) unsigned char lds_raw[];
    LAS unsigned char* lds = (LAS unsigned char*)lds_raw;
    volatile LAS unsigned* MISC = (volatile LAS unsigned*)(lds + MISC_OFF);
    LAS unsigned char* ring = lds + RING_OFF;
    LAS int* tab = (LAS int*)(lds + TAB_OFF);
    const int wave = __builtin_amdgcn_readfirstlane((int)threadIdx.x >> 6);
#define PHASE_TID() int tid = threadIdx.x; asm volatile("" : "+v"(tid)); const int lane = tid & 63; (void)lane
    const int G = gridDim.x, bx = blockIdx.x;
    const int vcu = (G % 8 == 0) ? (bx % 8) * (G / 8) + bx / 8 : bx;
    const int gw = bx * 8 + wave, NGW = G * 8, NGT = G * 512;
    unsigned char* ws = args.ws;
    unsigned* ctl = (unsigned*)(ws + WS_CTL);
#define WSP(T, off) ((T*)(opaque(ws) + (off)))
    if (threadIdx.x < 128) ((LAS unsigned*)(lds + MISC_OFF))[threadIdx.x] = 0u;
    __syncthreads();
    XcdBarrier bar; bar.bar = ctl + CW_BAR; bar.x = 0; bar.st = nullptr;
    if (MK_N_LAUNCHES == 1) bar = xcd_barrier_post(ctl + CW_BAR, MISC + 8);
    const int lo = args.ph_lo, hi = args.ph_hi;
#ifndef PHMASK
#define PHMASK 0x3ff
#endif
#define EN(bit) ((PHMASK >> (bit)) & 1)
#define IN(k) (lo <= (k) && (k) < hi)
#define SEAM(k) do { if (MK_N_LAUNCHES == 1) { if ((k) + 1 < hi) xcd_barrier(bar); } } while (0)

    if (EN(0) && IN(0)) {
        PHASE_TID(); const int gt = bx * 512 + tid;
        const float* cvec = args.in[1]; const float* cctx = args.in[3]; const float* w_mod = args.in[4];
        float* PART = WSP(float, WS_PART); bf16_t* WQKV = WSP(bf16_t, WS_WQKV); bf16_t* WO = WSP(bf16_t, WS_WO); bf16_t* WGU = WSP(bf16_t, WS_WGU); bf16_t* WD = WSP(bf16_t, WS_WD);
        float* ROPE128 = WSP(float, WS_ROPE); float* ROPE64 = WSP(float, WS_ROPE + 16384); float* WR = WSP(float, WS_WR);
        LAS float* SL = (LAS float*)ring;
        for (int i = tid; i < 9 * 1024; i += 512) { const int bb = i >> 10, k = i & 1023; const float c = bb < 8 ? cvec[bb * 1024 + k] : cctx[k]; SL[i] = c / (1.0f + expf(-c)); }
        __syncthreads();
        for (int it = gw; it < 4 * 24 * KSPLIT; it += NGW) {
            const int ks = it % KSPLIT, cb = (it / KSPLIT) % 24, l = it / (KSPLIT * 24);
            f32x4 acc[9];
#pragma unroll
            for (int bb = 0; bb < 9; ++bb) acc[bb] = (f32x4){0.f, 0.f, 0.f, 0.f};
            const float* w = w_mod + ((size_t)l * 1024 + ks * 64) * 6144 + cb * 256 + 4 * lane;
#pragma unroll 8
            for (int kk = 0; kk < 64; ++kk) { const f32x4 wv = *(const f32x4*)(w + (size_t)kk * 6144);
#pragma unroll
                for (int bb = 0; bb < 9; ++bb) acc[bb] += SL[bb * 1024 + ks * 64 + kk] * wv; }
#pragma unroll
            for (int bb = 0; bb < 9; ++bb) *(f32x4*)(PART + (((size_t)ks * 4 + l) * 9 + bb) * 6144 + cb * 256 + 4 * lane) = acc[bb];
        }
        __syncthreads();
        LAS float* scr = (LAS float*)ring + wave * (64 * 65);
        constexpr int T_QKV = 1920, T_WO = 1024, T_GU = 32768, T_DN = 16384, T_ALL = T_QKV + T_WO + T_GU + T_DN;
        for (int id0 = gw; id0 < T_ALL; id0 += NGW) {
            int id = id0;
            if (id < T_QKV) {
                int l, r; if (id < 384) { l = 0; r = id; } else if (id < 768) { l = 1; r = id - 384; } else if (id < 1536) { l = 2; r = id - 768; } else { l = 3; r = id - 1536; }
                const int N = (l == 2) ? 3072 : 1536, nbN = N / 64, kb = r / nbN, nb = r % nbN;
                const float* src = (l == 0) ? args.in[8] : (l == 1) ? args.in[12] : (l == 2) ? args.in[15] : args.in[8] + (size_t)1024 * 1536;
                const int drow = (l == 0) ? 0 : (l == 1) ? 1536 : (l == 2) ? 3072 : 6144;
                const bool perm = (l == 0 || l == 3) && (nb * 64 < 1280);
                transpose_tile(src, N, kb * 64, nb * 64, WQKV, 1024, drow + nb * 64, perm, scr, lane);
            } else if ((id -= T_QKV) < T_WO) {
                const int l = id >> 8, r = id & 255, kb = r >> 4, nb = r & 15;
                const float* src = (l == 0) ? args.in[11] : (l == 1) ? args.in[14] : (l == 2) ? args.in[21] : args.in[11] + (size_t)1024 * 1024;
                transpose_tile(src, 1024, kb * 64, nb * 64, WO + (size_t)l * 1024 * 1024, 1024, nb * 64, false, scr, lane);
            } else if ((id -= T_WO) < T_GU) {
                const int which = id >> 14, r = id & 16383, lge = r >> 7, rr = r & 127, kb = rr >> 3, nb = rr & 7;
                const float* src = (which ? args.in[27] : args.in[26]) + (size_t)lge * 1024 * 512;
                const int n0 = nb * 64, drow = lge * 1024 + (n0 >> 7) * 256 + which * 128 + (n0 & 127);
                transpose_tile(src, 512, kb * 64, n0, WGU, 1024, drow, false, scr, lane);
            } else {
                id -= T_GU; const int lge = id >> 7, rr = id & 127, kb = rr >> 4, nb = rr & 15;
                const float* src = args.in[28] + (size_t)lge * 512 * 1024;
                transpose_tile(src, 1024, kb * 64, nb * 64, WD, 512, lge * 1024 + nb * 64, false, scr, lane);
            }
        }
        for (int i = gt; i < 64 * 32 + 64 * 16; i += NGT) {
            const bool big = i < 2048; const int ii = big ? i : i - 2048, NF = big ? 32 : 16, pos = ii / NF, f = ii % NF;
            const double base = big ? 0.7498942093324559 : 0.5623413251903491; double inv = 1.0;
            for (int q = 0; q < f; ++q) inv *= base;
            const float ang = (float)pos * (float)inv; double s, c; sincos_small((double)ang, s, c);
            float* Tt = big ? ROPE128 : ROPE64; Tt[ii] = (float)c; Tt[64 * NF + ii] = (float)s;
        }
        { const float* wg = args.in[22]; const float* we = args.in[24];
          for (int i = gt; i < 4 * 36 * 1024; i += NGT) { const int l = i / (36 * 1024), e = (i >> 10) % 36, c = i & 1023;
              WR[i] = (e < 4) ? wg[((size_t)l * 1024 + c) * 4 + e] : we[((size_t)l * 1024 + c) * 32 + (e - 4)]; } }
        SEAM(0);
    }
    if (EN(1) && IN(1)) {
        PHASE_TID(); const int gt = bx * 512 + tid;
        const float* b_mod = args.in[5]; float* PART = WSP(float, WS_PART); float* MOD = WSP(float, WS_MOD);
        for (int i = gt; i < 4 * 9 * 6144; i += NGT) { const int l = i / 55296, bbj = i % 55296, j = bbj % 6144; float s = b_mod[l * 6144 + j];
#pragma unroll
            for (int ks = 0; ks < KSPLIT; ++ks) s += PART[((size_t)ks * 4 + l) * 55296 + bbj];
            MOD[i] = s; }
        SEAM(1);
    }
    if (EN(1) && IN(2)) {
        PHASE_TID();
        const float* xin = args.in[0]; const float* cin = args.in[2]; float* MOD = WSP(float, WS_MOD); float* X = WSP(float, WS_X); bf16_t* HB = WSP(bf16_t, WS_HB);
        for (int row = gw; row < MROWS; row += NGW) {
            const int b = row / TPB, t = row % TPB; const bool is_ctx = t >= SEQ; const int bb = is_ctx ? 8 : b;
            const float* src = is_ctx ? cin + ((size_t)b * CTXL + (t - SEQ)) * DM : xin + ((size_t)b * SEQ + t) * DM;
            const float* mv = MOD + (size_t)bb * 6144;
#pragma unroll
            for (int j = 0; j < 4; ++j) { const int c = 4 * lane + 256 * j; const f32x4 v = *(const f32x4*)(src + c);
                *(f32x4*)(X + (size_t)row * DM + c) = v;
                const f32x4 sh = *(const f32x4*)(mv + c), sc = *(const f32x4*)(mv + 1024 + c); const f32x4 h = v * (sc + 1.0f) + sh;
                u32x2 w; w.x = cvt_pk_bf16(h[0], h[1]); w.y = cvt_pk_bf16(h[2], h[3]); *(u32x2*)(HB + (size_t)row * DM + c) = w; }
        }
        SEAM(2);
    }
#pragma unroll 1
    for (int l = 0; l < DEPTH; ++l) {
        const int kind = l % 3, P = 3 + 7 * l; const bool lastl = (l == DEPTH - 1);
#define MODL (WSP(float, WS_MOD) + (size_t)l * 9 * 6144)
        const int wq_row = (l == 0) ? 0 : (l == 1) ? 1536 : (l == 2) ? 3072 : 6144;
        const int NQ = (kind == 2) ? 3072 : 1536;
#define CNTL ((unsigned*)opaque(ws) + CW_CNT + l * 64)
        if (EN(2) && IN(P + 0)) {
            DenseSched S; S.init(WSP(bf16_t, WS_HB), WSP(bf16_t, WS_WQKV) + (size_t)wq_row * 1024, 1024, 72, NQ / 256, G, bx, 0); bf16_t* qkv_o = WSP(bf16_t, WS_QKV);
            if (EN(7) && kind == 0) { EpiQKV<0> E{qkv_o, NQ, WSP(float, WS_ROPE), args.in[9] + (l / 3) * 128, args.in[10] + (l / 3) * 128, (LAS float*)(lds + SS_OFF)}; pg8::gemm_phase(ring, 1024, S, E); }
            else if (EN(8) && kind == 1) { EpiQKV<1> E{qkv_o, NQ, WSP(float, WS_ROPE + 16384), nullptr, nullptr, nullptr}; pg8::gemm_phase(ring, 1024, S, E); }
            else if (EN(9) && kind == 2) { EpiQKV<2> E{qkv_o, NQ, WSP(float, WS_ROPE + 16384), nullptr, nullptr, nullptr}; pg8::gemm_phase(ring, 1024, S, E); }
            SEAM(P + 0);
        }
        if (EN(3) && IN(P + 1)) {
            LAS char* alds = (LAS char*)ring; bf16_t* QKV = WSP(bf16_t, WS_QKV); bf16_t* OB = WSP(bf16_t, WS_O); float* STASH = WSP(float, WS_STASH) + (size_t)bx * (64 * 512);
            PHASE_TID(); const int r32 = lane & 31, hh = lane >> 5;
            if (EN(7) && kind == 0) {
                LAS float* wsf = (LAS float*)(alds + 4 * 16384) + wave * 64;
                const int nlat = 512, nall = nlat + (lastl ? 0 : 64);
                for (int u = vcu; u < nall; u += G) {
                    int b, hq, q0, NT, base1;
                    if (u < nlat) { const int qb = u & 7, g = (u >> 3) & 3, kv = (u >> 5) & 1; b = u >> 6; hq = kv * 4 + g; q0 = qb * 256; NT = 36; base1 = 0; }
                    else { const int uc = u - nlat; hq = uc & 7; b = uc >> 3; q0 = 2048; NT = 4; base1 = 2048; }
                    const int kv = hq >> 2; const size_t rb = (size_t)b * TPB;
                    f32x16 o[4]; float m, lsum;
                    att::attn_core<128, 128, false>(opaque(QKV) + (rb + q0) * 1536 + hq * 128, 1536, opaque(QKV) + rb * 1536 + 1024 + kv * 128, opaque(QKV) + rb * 1536 + 1280 + kv * 128, 1536, NT, NT, base1, 0, 0, alds, o, m, lsum);
                    float rl[16]; att::row_bcast(wsf, 1.0f / lsum, r32, hh, rl);
                    bf16_t* Ow = opaque(OB) + (rb + q0 + wave * 32) * DM + hq * 128 + r32;
#pragma unroll
                    for (int r = 0; r < 16; ++r) { const int orow = att::crow(r, hh);
#pragma unroll
                        for (int d0 = 0; d0 < 4; ++d0) Ow[(size_t)orow * DM + d0 * 32] = (bf16_t)(cvt_pk_bf16(o[d0][r] * rl[r], 0.f) & 0xffffu); }
                }
            } else if (EN(8) && kind == 1) {
                LAS float* wsf = (LAS float*)(alds + 4 * 8192) + wave * 64;
                const float* sink = opaque(args.in[13]);
                const int nlat = 1024, nall = nlat + (lastl ? 0 : 128);
                for (int u = vcu; u < nall; u += G) {
                    int b, hq, q0, NT, base2;
                    if (u < nlat) { const int qb = u & 7, g = (u >> 3) & 3, kv = (u >> 5) & 3; b = u >> 7; hq = kv * 4 + g; q0 = qb * 256;
                        const int klo = (q0 - 128) < 0 ? 0 : q0 - 128, khi = (q0 + 384) > SEQ ? SEQ : q0 + 384; base2 = klo; NT = 4 + (khi - klo) / 64; }
                    else { const int uc = u - nlat; hq = uc & 15; b = uc >> 4; q0 = 2048; NT = 4; base2 = 0; }
                    const int kv = hq >> 2; const size_t rb = (size_t)b * TPB;
                    f32x16 o[2]; float m, lsum;
                    att::attn_core<64, 64, true>(opaque(QKV) + (rb + q0) * 1536 + hq * 64, 1536, opaque(QKV) + rb * 1536 + 1024 + kv * 64, opaque(QKV) + rb * 1536 + 1280 + kv * 64, 1536, NT, 4, 2048, base2, q0, alds, o, m, lsum);
                    lsum += exp2f(sink[hq] * 1.4426950408889634f - m * (0.125f * 1.4426950408889634f));
                    float rl[16]; att::row_bcast(wsf, 1.0f / lsum, r32, hh, rl);
                    bf16_t* Ow = opaque(OB) + (rb + q0 + wave * 32) * DM + hq * 64 + r32;
#pragma unroll
                    for (int r = 0; r < 16; ++r) { const int orow = att::crow(r, hh);
#pragma unroll
                        for (int d0 = 0; d0 < 2; ++d0) Ow[(size_t)orow * DM + d0 * 32] = (bf16_t)(cvt_pk_bf16(o[d0][r] * rl[r], 0.f) & 0xffffu); }
                }
            } else if (EN(9) && kind == 2) {
                LAS float* wsf = (LAS float*)(alds + 2 * 16384 + 2 * 8192) + wave * 64;
                const float lam = expf(wave_sum(opaque(args.in[16])[lane] * opaque(args.in[17])[lane])) - expf(wave_sum(opaque(args.in[18])[lane] * opaque(args.in[19])[lane])) + LAM_INIT_C;
                const float* sg = opaque(args.in[20]);
                const int nlat = 512, nall = nlat + (lastl ? 0 : 64);
                for (int u = vcu; u < nall; u += G) {
                    int b, h, q0, NT, base1;
                    if (u < nlat) { const int qb = u & 7; h = (u >> 3) & 7; b = u >> 6; q0 = qb * 256; NT = 36; base1 = 0; }
                    else { const int uc = u - nlat; h = uc & 7; b = uc >> 3; q0 = 2048; NT = 4; base1 = 2048; }
                    const size_t rb = (size_t)b * TPB;
#pragma unroll 1
                    for (int mp = 0; mp < 2; ++mp) {
                        f32x16 o[4]; float m, lsum; float rl[16];
                        att::attn_core<64, 128, false>(opaque(QKV) + (rb + q0) * 3072 + h * 128 + mp * 64, 3072, opaque(QKV) + rb * 3072 + 1024 + h * 128 + mp * 64, opaque(QKV) + rb * 3072 + 2048 + h * 128, 3072, NT, NT, base1, 0, 0, alds, o, m, lsum);
                        att::row_bcast(wsf, 1.0f / lsum, r32, hh, rl);
                        float* st = opaque(STASH) + tid;
                        if (mp == 0) {
#pragma unroll
                            for (int d0 = 0; d0 < 4; ++d0)
#pragma unroll
                                for (int r = 0; r < 16; ++r) st[(d0 * 16 + r) * 512] = o[d0][r] * rl[r];
                        } else {
                            const f32x4 gv = (f32x4){sg[r32], sg[32 + r32], sg[64 + r32], sg[96 + r32]};
                            bf16_t* Ow = opaque(OB) + (rb + q0 + wave * 32) * DM + h * 128 + r32;
#pragma unroll
                            for (int r = 0; r < 16; ++r) { float v[4]; float ss = 0.f;
#pragma unroll
                                for (int d0 = 0; d0 < 4; ++d0) { v[d0] = st[(d0 * 16 + r) * 512] - lam * (o[d0][r] * rl[r]); ss += v[d0] * v[d0]; }
                                ss += __shfl_xor(ss, 1); ss += __shfl_xor(ss, 2); ss += __shfl_xor(ss, 4); ss += __shfl_xor(ss, 8); ss += __shfl_xor(ss, 16);
                                const float rinv = (1.0f - LAM_INIT_C) / sqrtf(ss * (1.0f / 128.0f) + RMS_EPS); const int orow = att::crow(r, hh);
#pragma unroll
                                for (int d0 = 0; d0 < 4; ++d0) Ow[(size_t)orow * DM + d0 * 32] = (bf16_t)(cvt_pk_bf16(v[d0] * rinv * gv[d0], 0.f) & 0xffffu);
                                if ((r & 3) == 3) asm volatile("" ::: "memory"); }
                        }
                    }
                }
            }
            SEAM(P + 1);
        }
        if (EN(4) && IN(P + 2)) {
            DenseSched S; S.init(WSP(bf16_t, WS_O), WSP(bf16_t, WS_WO) + (size_t)l * 1024 * 1024, 1024, lastl ? 64 : 72, 4, G, bx, lastl ? 1 : 0);
            EpiWo E{WSP(float, WS_X), WSP(float, WS_Y), MODL};
            pg8::gemm_phase(ring, 1024, S, E);
            SEAM(P + 2);
        }
        if (EN(5) && IN(P + 3)) {
            const float* lg = opaque(args.in[6] + (size_t)(l * 2 + 0) * 1024); const float* lb = opaque(args.in[7] + (size_t)(l * 2 + 0) * 1024);
            const float* wr = WSP(float, WS_WR) + (size_t)l * 36 * 1024; const float* bg = opaque(args.in[23] + l * 4); const float* be = opaque(args.in[25] + l * 32);
            float* X = WSP(float, WS_X); float* Y = WSP(float, WS_Y); bf16_t* HB = WSP(bf16_t, WS_HB); const float* modl = MODL; u32x4* TOK = WSP(u32x4, WS_TOK); int* LIST = WSP(int, WS_LIST); unsigned* cnt = CNTL;
            PHASE_TID();
            for (int row = gw; row < MROWS; row += NGW) {
                const int b = row / TPB, t = row % TPB; const bool is_ctx = t >= SEQ; if (lastl && is_ctx) continue;
                const int bb = is_ctx ? 8 : b; const float* mv = modl + (size_t)bb * 6144;
                f32x4 y[4]; float s = 0.f;
#pragma unroll
                for (int j = 0; j < 4; ++j) { y[j] = *(const f32x4*)(Y + (size_t)row * DM + 4 * lane + 256 * j); s += (y[j][0] + y[j][1]) + (y[j][2] + y[j][3]); }
                const float mean = wave_sum(s) * (1.0f / 1024.0f); float s2 = 0.f;
#pragma unroll
                for (int j = 0; j < 4; ++j) { y[j] = y[j] - mean; s2 += (y[j][0] * y[j][0] + y[j][1] * y[j][1]) + (y[j][2] * y[j][2] + y[j][3] * y[j][3]); }
                const float rstd = 1.0f / sqrtf(wave_sum(s2) * (1.0f / 1024.0f) + LN_EPS);
                f32x4 h[4];
#pragma unroll
                for (int j = 0; j < 4; ++j) { const int c = 4 * lane + 256 * j;
                    const f32x4 xn = y[j] * rstd * *(const f32x4*)(lg + c) + *(const f32x4*)(lb + c);
                    *(f32x4*)(X + (size_t)row * DM + c) = xn;
                    h[j] = xn * (*(const f32x4*)(mv + 4096 + c) + 1.0f) + *(const f32x4*)(mv + 3072 + c);
                    u32x2 w; w.x = cvt_pk_bf16(h[j][0], h[j][1]); w.y = cvt_pk_bf16(h[j][2], h[j][3]); *(u32x2*)(HB + (size_t)row * DM + c) = w; }
                float gl[4];
#pragma unroll
                for (int e = 0; e < 4; ++e) { float p = 0.f;
#pragma unroll
                    for (int j = 0; j < 4; ++j) { const f32x4 w = *(const f32x4*)(wr + (size_t)e * 1024 + 4 * lane + 256 * j); p += (h[j][0] * w[0] + h[j][1] * w[1]) + (h[j][2] * w[2] + h[j][3] * w[3]); }
                    gl[e] = wave_sum(p) + bg[e]; }
                int gsel = 0; float gmax = gl[0];
#pragma unroll
                for (int e = 1; e < 4; ++e) if (gl[e] > gmax) { gmax = gl[e]; gsel = e; }
                float gden = 0.f;
#pragma unroll
                for (int e = 0; e < 4; ++e) gden += expf(gl[e] - gmax);
                const float gprob = 1.0f / gden;
                float el[8];
#pragma unroll
                for (int e = 0; e < 8; ++e) { float p = 0.f; const float* wp = wr + (size_t)(4 + gsel * 8 + e) * 1024;
#pragma unroll
                    for (int j = 0; j < 4; ++j) { const f32x4 w = *(const f32x4*)(wp + 4 * lane + 256 * j); p += (h[j][0] * w[0] + h[j][1] * w[1]) + (h[j][2] * w[2] + h[j][3] * w[3]); }
                    el[e] = wave_sum(p) + be[gsel * 8 + e]; }
                int i1 = 0; float v1 = el[0];
#pragma unroll
                for (int e = 1; e < 8; ++e) if (el[e] > v1) { v1 = el[e]; i1 = e; }
                int i2 = -1; float v2 = -3.0e38f;
#pragma unroll
                for (int e = 0; e < 8; ++e) if (e != i1 && el[e] > v2) { v2 = el[e]; i2 = e; }
                const float ex = expf(v2 - v1), w1 = gprob / (1.0f + ex), w2 = gprob * ex / (1.0f + ex);
                if (lane == 0) {
                    const int e1 = gsel * 8 + i1, e2 = gsel * 8 + i2;
                    const unsigned p1 = atomicAdd(cnt + e1, 1u), p2 = atomicAdd(cnt + e2, 1u);
                    LIST[(size_t)e1 * MROWS + p1] = row; LIST[(size_t)e2 * MROWS + p2] = row;
                    TOK[row] = (u32x4){(unsigned)e1 | (p1 << 8), __float_as_uint(w1), (unsigned)e2 | (p2 << 8), __float_as_uint(w2)};
                }
            }
            SEAM(P + 3);
        }
        if (IN(P + 4) || IN(P + 5) || IN(P + 6)) {
            PHASE_TID();
            __syncthreads();
            if (tid < 32) tab[tid] = (int)__hip_atomic_load((GAS unsigned*)CNTL + tid, RLX_AGENT);
            __syncthreads();
            if (tid == 0) { int p = 0; for (int e = 0; e < 32; ++e) { tab[32 + e] = p; p += (tab[e] + 255) >> 8; } tab[64] = p; }
            __syncthreads();
        }
        if (EN(6) && IN(P + 4)) {
            MoeGuSched S{(const char*)WSP(bf16_t, WS_HB), (const char*)(WSP(bf16_t, WS_WGU) + (size_t)l * 32 * 1024 * 1024), WSP(int, WS_LIST), tab, G, vcu};
            EpiGU E{WSP(bf16_t, WS_HID)};
            pg8::gemm_phase(ring, 1024, S, E);
            SEAM(P + 4);
        }
        if (EN(6) && IN(P + 5)) {
            MoeDownSched S{(const char*)WSP(bf16_t, WS_HID), (const char*)(WSP(bf16_t, WS_WD) + (size_t)l * 32 * 1024 * 512), tab, G, vcu};
            EpiDown E{WSP(bf16_t, WS_YS)};
            pg8::gemm_phase(ring, 512, S, E);
            SEAM(P + 5);
        }
        if (EN(5) && IN(P + 6)) {
            const float* lg = opaque(args.in[6] + (size_t)(l * 2 + 1) * 1024); const float* lb = opaque(args.in[7] + (size_t)(l * 2 + 1) * 1024);
            float* X = WSP(float, WS_X); bf16_t* HB = WSP(bf16_t, WS_HB); const float* modl = MODL; u32x4* TOK = WSP(u32x4, WS_TOK); bf16_t* YS = WSP(bf16_t, WS_YS); float* MOD = WSP(float, WS_MOD); float* outp = opaque(args.out);
            PHASE_TID();
            for (int row = gw; row < MROWS; row += NGW) {
                const int b = row / TPB, t = row % TPB; const bool is_ctx = t >= SEQ; if (lastl && is_ctx) continue;
                const int bb = is_ctx ? 8 : b; const float* mv = modl + (size_t)bb * 6144;
                const u32x4 tk = TOK[row];
                const int e1 = tk.x & 255, p1 = tk.x >> 8, e2 = tk.z & 255, p2 = tk.z >> 8; const float w1 = __uint_as_float(tk.y), w2 = __uint_as_float(tk.w);
                const bf16_t* ya = YS + ((size_t)tab[32 + e1] * 256 + p1) * DM; const bf16_t* yb = YS + ((size_t)tab[32 + e2] * 256 + p2) * DM;
                f32x4 y[4]; float s = 0.f;
#pragma unroll
                for (int j = 0; j < 4; ++j) { const int c = 4 * lane + 256 * j;
                    const u32x2 a = *(const u32x2*)(ya + c), bq = *(const u32x2*)(yb + c);
                    f32x4 f; f[0] = w1 * __uint_as_float(a.x << 16) + w2 * __uint_as_float(bq.x << 16); f[1] = w1 * __uint_as_float(a.x & 0xffff0000u) + w2 * __uint_as_float(bq.x & 0xffff0000u);
                    f[2] = w1 * __uint_as_float(a.y << 16) + w2 * __uint_as_float(bq.y << 16); f[3] = w1 * __uint_as_float(a.y & 0xffff0000u) + w2 * __uint_as_float(bq.y & 0xffff0000u);
                    y[j] = *(const f32x4*)(X + (size_t)row * DM + c) * ALPHA + *(const f32x4*)(mv + 5120 + c) * f;
                    s += (y[j][0] + y[j][1]) + (y[j][2] + y[j][3]); }
                const float mean = wave_sum(s) * (1.0f / 1024.0f); float s2 = 0.f;
#pragma unroll
                for (int j = 0; j < 4; ++j) { y[j] = y[j] - mean; s2 += (y[j][0] * y[j][0] + y[j][1] * y[j][1]) + (y[j][2] * y[j][2] + y[j][3] * y[j][3]); }
                const float rstd = 1.0f / sqrtf(wave_sum(s2) * (1.0f / 1024.0f) + LN_EPS);
                const float* mvn = MOD + ((size_t)(l + 1) * 9 + bb) * 6144;
#pragma unroll
                for (int j = 0; j < 4; ++j) { const int c = 4 * lane + 256 * j;
                    const f32x4 xn = y[j] * rstd * *(const f32x4*)(lg + c) + *(const f32x4*)(lb + c);
                    if (!lastl) { *(f32x4*)(X + (size_t)row * DM + c) = xn;
                        const f32x4 hv = xn * (*(const f32x4*)(mvn + 1024 + c) + 1.0f) + *(const f32x4*)(mvn + c);
                        u32x2 w; w.x = cvt_pk_bf16(hv[0], hv[1]); w.y = cvt_pk_bf16(hv[2], hv[3]); *(u32x2*)(HB + (size_t)row * DM + c) = w; }
                    else *(f32x4*)(outp + ((size_t)b * SEQ + t) * DM + c) = xn; }
            }
            SEAM(P + 6);
        }
    }
#undef IN
#undef SEAM
}

extern "C" void kernel_launch(void* const* d_in, const int* in_sizes, int n_in, void* d_out, int out_size, void* d_ws, size_t ws_size, hipStream_t stream) {
    static int grid = 0;
    if (grid == 0) {
        if (n_in != 29 || in_sizes[0] != NB * SEQ * DM || out_size != NB * SEQ * DM || ws_size < WS_END) { fprintf(stderr, "kernel_launch: unexpected shapes / workspace (n_in %d, ws %zu)\n", n_in, ws_size); grid = -1; return; }
        int dev = 0, cus = 0, per_cu = 0;
        if (hipGetDevice(&dev) != hipSuccess || hipDeviceGetAttribute(&cus, hipDeviceAttributeMultiprocessorCount, dev) != hipSuccess) { grid = -1; return; }
        if (hipFuncSetAttribute((const void*)fwd, hipFuncAttributeMaxDynamicSharedMemorySize, LDS_BYTES) != hipSuccess) { fprintf(stderr, "kernel_launch: hipFuncSetAttribute failed\n"); grid = -1; return; }
        if (hipOccupancyMaxActiveBlocksPerMultiprocessor(&per_cu, (const void*)fwd, 512, LDS_BYTES) != hipSuccess || per_cu < 1) fprintf(stderr, "kernel_launch: occupancy query says %d\n", per_cu);
        (void)hipGetLastError();
        grid = cus;
    }
    if (grid < 0) return;
    if (hipMemsetAsync((char*)d_ws + WS_CTL, 0, CTL_ZERO_BYTES, stream) != hipSuccess) return;
    Args a{};
    for (int i = 0; i < 29; ++i) a.in[i] = (const float*)d_in[i];
    a.out = (float*)d_out; a.ws = (unsigned char*)d_ws;
    if (MK_N_LAUNCHES == 1) { a.ph_lo = 0; a.ph_hi = NPHASE; hipLaunchKernelGGL(fwd, dim3(grid), dim3(512), LDS_BYTES, stream, a); }
    else for (int p = 0; p < NPHASE; ++p) { a.ph_lo = p; a.ph_hi = p + 1; hipLaunchKernelGGL(fwd, dim3(grid), dim3(512), LDS_BYTES, stream, a); }
    const hipError_t le = hipPeekAtLastError();
    if (le != hipSuccess) fprintf(stderr, "kernel_launch: launch failed: %s\n", hipGetErrorName(le));
}
```

```cpp
#include <hip/hip_runtime.h>
#include <hip/hip_bf16.h>
#include <cstdio>
#include <cstdint>

#ifndef MK_N_LAUNCHES
#define MK_N_LAUNCHES 1
#endif

#define LAS __attribute__((address_space(3)))
#define GAS __attribute__((address_space(1)))
typedef unsigned short bf16_t;
typedef short bf16x8 __attribute__((ext_vector_type(8)));
typedef short s16x4 __attribute__((ext_vector_type(4)));
typedef float f32x2 __attribute__((ext_vector_type(2)));
typedef float f32x4 __attribute__((ext_vector_type(4)));
typedef float f32x16 __attribute__((ext_vector_type(16)));
typedef unsigned u32x2 __attribute__((ext_vector_type(2)));
typedef unsigned u32x4 __attribute__((ext_vector_type(4)));

constexpr int DM = 1024, NB = 8, SEQ = 2048, CTXL = 256, TPB = SEQ + CTXL, MROWS = NB * TPB;
constexpr int DEPTH = 4, NEXP = 32, EFF = 512;
constexpr float ALPHA = 1.6817928305074292f;
constexpr float LN_EPS = 1e-5f, RMS_EPS = 1e-6f;
constexpr float LAM_INIT_C = 0.47071301834358416f;
constexpr int KSPLIT = 16;

constexpr size_t MiB = 1u << 20;
constexpr size_t WS_CTL = 0, CTL_ZERO_BYTES = 1 * MiB;
constexpr size_t WS_MOD = 1 * MiB;
constexpr size_t WS_ROPE = 2 * MiB;
constexpr size_t WS_WR = 2 * MiB + 64 * 1024;
constexpr size_t WS_PART = 3 * MiB;
constexpr size_t WS_TOK = 17 * MiB;
constexpr size_t WS_LIST = 18 * MiB;
constexpr size_t WS_WQKV = 21 * MiB;
constexpr size_t WS_WO = 36 * MiB;
constexpr size_t WS_WGU = 44 * MiB;
constexpr size_t WS_WD = 300 * MiB;
constexpr size_t WS_X = 428 * MiB;
constexpr size_t WS_Y = 500 * MiB;
constexpr size_t WS_HB = 572 * MiB;
constexpr size_t WS_QKV = 608 * MiB;
constexpr size_t WS_O = 716 * MiB;
constexpr size_t WS_HID = WS_QKV;
constexpr size_t WS_YS = 652 * MiB;
constexpr size_t WS_STASH = 752 * MiB;
constexpr size_t WS_END = 784 * MiB;
constexpr int MAXSLOT = 45056;
constexpr int CW_TMO = 0, CW_CODE = 1, CW_BAR = 4096, CW_CNT = 8192;

constexpr int MISC_OFF = 0;
constexpr int RING_OFF = 512, RING_BYTES = 131072;
constexpr int SS_OFF = RING_OFF + RING_BYTES;
constexpr int TAB_OFF = SS_OFF + 16384;
constexpr int LDS_BYTES = TAB_OFF + 1024;

#define RLX_AGENT __ATOMIC_RELAXED, __HIP_MEMORY_SCOPE_AGENT
template <class T> __device__ __forceinline__ T* opaque(T* p) { size_t z = 0; asm volatile("" : "+s"(z)); return (T*)((char*)p + z); }
__device__ __forceinline__ unsigned cvt_pk_bf16(float lo, float hi) { unsigned r; asm volatile("v_cvt_pk_bf16_f32 %0, %1, %2" : "=v"(r) : "v"(lo), "v"(hi)); return r; }
__device__ __forceinline__ float bf2f(unsigned short h) { return __uint_as_float(((unsigned)h) << 16); }
__device__ __forceinline__ float wave_sum(float v) {
#pragma unroll
    for (int o = 1; o < 64; o <<= 1) v += __shfl_xor(v, o);
    return v;
}

#define XB_TMO      128
#define XB_XCNT(j)  (256  + 64 * (j))
#define XB_XSUB(j)  (1280 + 64 * (j))
#define XB_XGEN(j)  (2304 + 64 * (j))
#define XB_TOP      3328
#define XB_TOPGEN   3392
#define XCD_BAR_WORDS 3456
#define XB_SPIN_CAP (1u << 18)
__device__ __forceinline__ unsigned xb_ld(unsigned* p)              { return __hip_atomic_load(p, __ATOMIC_RELAXED, __HIP_MEMORY_SCOPE_AGENT); }
__device__ __forceinline__ unsigned xb_add(unsigned* p, unsigned v) { return __hip_atomic_fetch_add(p, v, __ATOMIC_RELAXED, __HIP_MEMORY_SCOPE_AGENT); }
__device__ __forceinline__ unsigned xb_xcc_id() { return (unsigned)__builtin_amdgcn_s_getreg((3 << 11) | 20) & 0xFu; }
#define XB_SPIN(cond, bar) do { unsigned _sp = 0; while (cond) { __builtin_amdgcn_s_sleep(1); \
    if ((++_sp & 255u) == 0u) { if (xb_ld(&(bar)[XB_TMO])) break; if (_sp > XB_SPIN_CAP) { atomicAdd(&(bar)[XB_TMO], 1u); break; } } } } while (0)
struct XcdBarrier { unsigned* bar; unsigned x; volatile LAS unsigned* st; };
__device__ __forceinline__ XcdBarrier xcd_barrier_post(unsigned* bar, volatile LAS unsigned* st) {
    XcdBarrier b; b.bar = bar; b.x = xb_xcc_id(); b.st = st;
    if (threadIdx.x == 0) (void)xb_add(&bar[XB_XCNT(b.x)], 1u);
    return b;
}
__device__ __forceinline__ void xcd_barrier_complete(unsigned* bar, unsigned x, unsigned& nloc, unsigned& nx) {
    const unsigned G = gridDim.x * gridDim.y * gridDim.z;
    unsigned sum, cnt, mine, sp = 0u;
    for (;;) {
        sum = 0u; cnt = 0u; mine = 0u;
#pragma unroll
        for (unsigned j = 0; j < 16; ++j) { const unsigned c = xb_ld(&bar[XB_XCNT(j)]); sum += c; cnt += (c > 0u) ? 1u : 0u; mine = (j == x) ? c : mine; }
        if (sum == G) break;
        __builtin_amdgcn_s_sleep(1);
        if ((++sp & 255u) == 0u) { if (xb_ld(&bar[XB_TMO])) break; if (sp > XB_SPIN_CAP) { atomicAdd(&bar[XB_TMO], 1u); break; } }
    }
    nloc = mine > 0u ? mine : 1u; nx = cnt > 0u ? cnt : 1u;
}
__device__ __forceinline__ void xcd_barrier(const XcdBarrier& b) {
    asm volatile("s_waitcnt vmcnt(0)" ::: "memory");
    __syncthreads();
    if (threadIdx.x == 0) {
        unsigned* bar = b.bar;
        __builtin_amdgcn_s_waitcnt(0);
        unsigned nloc = b.st[0], nx = b.st[1];
        if (nloc == 0u) { xcd_barrier_complete(bar, b.x, nloc, nx); b.st[0] = nloc; b.st[1] = nx; }
        const unsigned old = xb_add(&bar[XB_XSUB(b.x)], 1u);
        const unsigned gen = old / nloc;
        if (old + 1u == (gen + 1u) * nloc) {
            __builtin_amdgcn_fence(__ATOMIC_RELEASE, "agent");
            asm volatile("s_waitcnt vmcnt(0)" ::: "memory");
            const unsigned og = xb_add(&bar[XB_TOP], 1u);
            const unsigned tg = og / nx;
            if (og + 1u == (tg + 1u) * nx) xb_add(&bar[XB_TOPGEN], 1u);
            else XB_SPIN(xb_ld(&bar[XB_TOPGEN]) == tg, bar);
            __builtin_amdgcn_fence(__ATOMIC_ACQUIRE, "agent");
            xb_add(&bar[XB_XGEN(b.x)], 1u);
            asm volatile("s_waitcnt vmcnt(0)" ::: "memory");
        } else {
            XB_SPIN(xb_ld(&bar[XB_XGEN(b.x)]) == gen, bar);
            __builtin_amdgcn_fence(__ATOMIC_ACQUIRE, "agent");
            asm volatile("s_waitcnt vmcnt(0)" ::: "memory");
        }
    }
    __syncthreads();
}

namespace pg8 {
constexpr int BM = 256, BK = 64, HALF = 128, HTB = HALF * BK * 2, STAGE_BYTES = 8 * HTB;
__device__ __forceinline__ int lds_byte(int r, int c) { const int st = (r >> 4) * 2 + (c >> 5), rr = r & 15, cc = c & 31, ob = rr * 64 + cc * 2; return st * 1024 + (ob ^ (((ob >> 9) & 1) << 5)); }
__device__ __forceinline__ void stage_rc(int b, int& R, int& C) { const int st = b / 1024, sb = b % 1024, swz = sb ^ (((sb >> 9) & 1) << 5); R = (st >> 1) * 16 + swz / 64; C = (st & 1) * 32 + (swz % 64) / 2; }
struct Unit { int pm, pn, e, nrow; };

template <class Epi, class Sched>
__device__ __forceinline__ void gemm_phase(LAS unsigned char* lds, const int K, const Sched& S, const Epi& E) {
    int tid = threadIdx.x; asm volatile("" : "+v"(tid));
    const int wid = __builtin_amdgcn_readfirstlane(tid >> 6), lane = tid & 63, wr = wid >> 2, wc = wid & 3, fr = lane & 15, fq = lane >> 4;
    const int nt = K / BK;
    unsigned voffB[2];
#pragma unroll
    for (int i = 0; i < 2; ++i) { int R_, C_; stage_rc(tid * 16 + i * 8192, R_, C_); voffB[i] = (unsigned)(R_ * K + C_) * 2u; }
    const size_t kstep = (size_t)(BK * 2);
    const size_t hstepB = (size_t)HALF * K * 2;
    const unsigned ldsw = (unsigned)wid * 1024u;
    const int aoff = lds_byte(wr * 64 + fr, fq * 8), boff = lds_byte(wc * 32 + fr, fq * 8);
#define PG8_SA(b, h) (((b) * 2 + (h)) * HTB)
#define PG8_SB(b, h) ((4 + (b) * 2 + (h)) * HTB)
#define PG8_STAGE(bufoff, gbase, voff) do { _Pragma("unroll") for (int _i = 0; _i < 2; ++_i) \
        __builtin_amdgcn_global_load_lds((const unsigned*)((const char*)(gbase) + (voff)[_i]), (LAS unsigned*)(lds + (bufoff) + ldsw + _i * 8192), 16, 0, 0); } while (0)
#define PG8_LDA(dst, b, h) do { _Pragma("unroll") for (int m = 0; m < 4; ++m) _Pragma("unroll") for (int k = 0; k < 2; ++k) dst[m][k] = *(const LAS bf16x8*)(lds + PG8_SA(b, h) + aoff + m * 2048 + k * 1024); } while (0)
#define PG8_LDB(dst, b, h) do { _Pragma("unroll") for (int n = 0; n < 2; ++n) _Pragma("unroll") for (int k = 0; k < 2; ++k) dst[n][k] = *(const LAS bf16x8*)(lds + PG8_SB(b, h) + boff + n * 2048 + k * 1024); } while (0)
#define PG8_MMA(ai, bj, At, Bt) do { __builtin_amdgcn_s_setprio(1); _Pragma("unroll") for (int m = 0; m < 4; ++m) _Pragma("unroll") for (int n = 0; n < 2; ++n) _Pragma("unroll") for (int k = 0; k < 2; ++k) \
        acc[ai][bj][m][n] = __builtin_amdgcn_mfma_f32_16x16x32_bf16(Bt[n][k], At[m][k], acc[ai][bj][m][n], 0, 0, 0); __builtin_amdgcn_s_setprio(0); } while (0)
#define PG8_WAIT_V(n) asm volatile("s_waitcnt vmcnt(" #n ")" ::: "memory")
#define PG8_WAIT_L(n) asm volatile("s_waitcnt lgkmcnt(" #n ")" ::: "memory")
#define PG8_BAR __builtin_amdgcn_s_barrier()
#define PG8_SCHED __builtin_amdgcn_sched_barrier(0)
    Unit cur, nxt; int ui = 0;
    if (!S.next(0, cur)) return;
    f32x4 acc[2][2][4][2];
#pragma unroll
    for (int a = 0; a < 2; ++a)
#pragma unroll
        for (int b = 0; b < 2; ++b)
#pragma unroll
            for (int m = 0; m < 4; ++m)
#pragma unroll
                for (int n = 0; n < 2; ++n) acc[a][b][m][n] = (f32x4){0.f, 0.f, 0.f, 0.f};
    bf16x8 At[4][2], B0[2][2], B1[2][2];
    unsigned vA0[2], vA1[2], nA0[2], nA1[2];
    S.a_voff(cur, tid, K, vA0, vA1);
    const char* cA = S.a_ptr(cur); const char* cB = S.b_ptr(cur);
    PG8_STAGE(PG8_SB(0, 0), cB, voffB); PG8_STAGE(PG8_SB(0, 1), cB + hstepB, voffB); PG8_STAGE(PG8_SA(0, 0), cA, vA0); PG8_STAGE(PG8_SA(0, 1), cA, vA1);
    if (wr == 1) PG8_BAR;
    PG8_WAIT_V(2); PG8_BAR;
    PG8_STAGE(PG8_SB(1, 0), cB + kstep, voffB); PG8_STAGE(PG8_SA(1, 0), cA + kstep, vA0); PG8_STAGE(PG8_SB(1, 1), cB + hstepB + kstep, voffB);
    PG8_WAIT_V(6); PG8_BAR;
    for (;;) {
        const bool has_next = S.next(ui + 1, nxt);
        const char* nA = cA; const char* nB = cB;
#pragma unroll
        for (int i = 0; i < 2; ++i) { nA0[i] = vA0[i]; nA1[i] = vA1[i]; }
        if (has_next) { nA = S.a_ptr(nxt); nB = S.b_ptr(nxt); S.a_voff(nxt, tid, K, nA0, nA1); }
        for (int t = 0; t < nt; t += 2) {
            const bool last = (t == nt - 2);
            const char* a1 = cA + (size_t)(t + 1) * kstep;
            const char* a2 = last ? nA : cA + (size_t)(t + 2) * kstep; const char* b2 = last ? nB : cB + (size_t)(t + 2) * kstep;
            const char* a3 = a2 + kstep; const char* b3 = b2 + kstep;
            PG8_LDB(B0, 0, 0); PG8_LDB(B1, 0, 1); PG8_SCHED; PG8_LDA(At, 0, 0); PG8_STAGE(PG8_SA(1, 1), a1, vA1);
            if (last) {
#pragma unroll
                for (int i = 0; i < 2; ++i) { vA0[i] = nA0[i]; vA1[i] = nA1[i]; } }
            PG8_WAIT_V(8); PG8_WAIT_L(0); PG8_BAR; PG8_MMA(0, 0, At, B0); PG8_MMA(0, 1, At, B1); PG8_BAR; PG8_SCHED;
            PG8_LDA(At, 0, 1); PG8_STAGE(PG8_SB(0, 0), b2, voffB); PG8_STAGE(PG8_SB(0, 1), b2 + hstepB, voffB); PG8_STAGE(PG8_SA(0, 0), a2, vA0);
            PG8_WAIT_V(8); PG8_WAIT_L(0); PG8_BAR; PG8_MMA(1, 0, At, B0); PG8_MMA(1, 1, At, B1); PG8_BAR; PG8_SCHED;
            PG8_LDB(B0, 1, 0); PG8_LDB(B1, 1, 1); PG8_SCHED; PG8_LDA(At, 1, 0); PG8_STAGE(PG8_SA(0, 1), a2, vA1);
            PG8_WAIT_V(8); PG8_WAIT_L(0); PG8_BAR; PG8_MMA(0, 0, At, B0); PG8_MMA(0, 1, At, B1); PG8_BAR; PG8_SCHED;
            PG8_LDA(At, 1, 1); PG8_STAGE(PG8_SB(1, 0), b3, voffB); PG8_STAGE(PG8_SB(1, 1), b3 + hstepB, voffB); PG8_STAGE(PG8_SA(1, 0), a3, vA0);
            PG8_WAIT_V(8); PG8_WAIT_L(0); PG8_BAR; PG8_MMA(1, 0, At, B0); PG8_MMA(1, 1, At, B1); PG8_BAR; PG8_SCHED;
        }
        if (wr == 0) PG8_BAR;
        E(acc, cur, ui, wr, wc, fr, fq);
        if (!has_next) break;
#pragma unroll
        for (int a = 0; a < 2; ++a)
#pragma unroll
            for (int b = 0; b < 2; ++b)
#pragma unroll
                for (int m = 0; m < 4; ++m)
#pragma unroll
                    for (int n = 0; n < 2; ++n) acc[a][b][m][n] = (f32x4){0.f, 0.f, 0.f, 0.f};
        cur = nxt; cA = nA; cB = nB; ++ui;
        if (wr == 1) PG8_BAR;
    }
    PG8_WAIT_V(0);
    PG8_BAR;
#undef PG8_SA
#undef PG8_SB
#undef PG8_STAGE
#undef PG8_LDA
#undef PG8_LDB
#undef PG8_MMA
#undef PG8_WAIT_V
#undef PG8_WAIT_L
#undef PG8_BAR
#undef PG8_SCHED
}
}

struct DenseSched {
    const char* A; const char* Bt; int K, nM, nN, nwg, G, c, latonly;
    __device__ __forceinline__ void init(const void* A_, const void* Bt_, int K_, int nM_, int nN_, int G_, int c_, int latonly_) { A = (const char*)A_; Bt = (const char*)Bt_; K = K_; nM = nM_; nN = nN_; nwg = nM * nN; G = G_; c = c_; latonly = latonly_; }
    __device__ __forceinline__ bool next(int i, pg8::Unit& u) const {
        const long L = (long)i * G + c; if (L >= nwg) return false;
        int wgid = (int)L; { const int q = nwg / 8, r = nwg % 8, xcd = wgid % 8, off = wgid / 8; wgid = (xcd < r ? xcd * (q + 1) : r * (q + 1) + (xcd - r) * q) + off; }
        const int nig = 8 * nN, gid = wgid / nig, fm = gid * 8, gsz = (nM - fm) < 8 ? (nM - fm) : 8;
        int pm = fm + ((wgid % nig) % gsz); u.pn = (wgid % nig) / gsz;
        if (latonly) pm = (pm >> 3) * 9 + (pm & 7);
        u.pm = pm; u.e = 0; u.nrow = 0; return true;
    }
    __device__ __forceinline__ const char* a_ptr(const pg8::Unit& u) const { return A + (size_t)u.pm * 256 * K * 2; }
    __device__ __forceinline__ const char* b_ptr(const pg8::Unit& u) const { return Bt + (size_t)u.pn * 256 * K * 2; }
    __device__ __forceinline__ void a_voff(const pg8::Unit&, int tid, int K_, unsigned (&v0)[2], unsigned (&v1)[2]) const {
#pragma unroll
        for (int i = 0; i < 2; ++i) { int R, C; pg8::stage_rc(tid * 16 + i * 8192, R, C); v0[i] = (unsigned)(R * K_ + C) * 2u; v1[i] = (unsigned)((128 + R) * K_ + C) * 2u; }
    }
};
__device__ __forceinline__ int moe_find(const LAS int* tab, int mt) { int e = 0;
#pragma unroll 1
    for (int j = 1; j < 32; ++j) e = (tab[32 + j] <= mt) ? j : e;
    return e; }
struct MoeGuSched {
    const char* HB; const char* W; const int* list; const LAS int* tab; int G, c;
    __device__ __forceinline__ bool next(int i, pg8::Unit& u) const {
        const int L = i * G + c, T = tab[64]; if (L >= 4 * T) return false;
        const int mt = L >> 2; u.pm = mt; u.pn = L & 3; const int e = moe_find(tab, mt); u.e = e; u.nrow = mt - tab[32 + e]; return true;
    }
    __device__ __forceinline__ const char* a_ptr(const pg8::Unit&) const { return HB; }
    __device__ __forceinline__ const char* b_ptr(const pg8::Unit& u) const { return W + ((size_t)u.e * 1024 + (size_t)u.pn * 256) * 1024 * 2; }
    __device__ __forceinline__ void a_voff(const pg8::Unit& u, int tid, int K_, unsigned (&v0)[2], unsigned (&v1)[2]) const {
        const int n = tab[u.e]; const int* lp = list + (size_t)u.e * MROWS;
#pragma unroll
        for (int i = 0; i < 2; ++i) { int R, C; pg8::stage_rc(tid * 16 + i * 8192, R, C);
            int i0 = u.nrow * 256 + R, i1 = i0 + 128; i0 = i0 < n ? i0 : n - 1; i1 = i1 < n ? i1 : n - 1;
            const int t0 = lp[i0], t1 = lp[i1];
            v0[i] = (unsigned)(t0 * K_ + C) * 2u; v1[i] = (unsigned)(t1 * K_ + C) * 2u; }
    }
};
struct MoeDownSched {
    const char* HID; const char* W; const LAS int* tab; int G, c;
    __device__ __forceinline__ bool next(int i, pg8::Unit& u) const {
        const int L = i * G + c, T = tab[64]; if (L >= 4 * T) return false;
        const int mt = L >> 2; u.pm = mt; u.pn = L & 3; u.e = moe_find(tab, mt); u.nrow = 0; return true;
    }
    __device__ __forceinline__ const char* a_ptr(const pg8::Unit& u) const { return HID + (size_t)u.pm * 256 * EFF * 2; }
    __device__ __forceinline__ const char* b_ptr(const pg8::Unit& u) const { return W + ((size_t)u.e * 1024 + (size_t)u.pn * 256) * EFF * 2; }
    __device__ __forceinline__ void a_voff(const pg8::Unit&, int tid, int K_, unsigned (&v0)[2], unsigned (&v1)[2]) const {
#pragma unroll
        for (int i = 0; i < 2; ++i) { int R, C; pg8::stage_rc(tid * 16 + i * 8192, R, C); v0[i] = (unsigned)(R * K_ + C) * 2u; v1[i] = (unsigned)((128 + R) * K_ + C) * 2u; }
    }
};

template <int KIND> struct EpiQKV {
    bf16_t* out; int ldo; const float* rope; const float* qg; const float* kg; LAS float* ss;
    __device__ __forceinline__ void operator()(f32x4 (&acc)[2][2][4][2], const pg8::Unit& u, int ui, int wr, int wc, int fr, int fq) const {
        const int pmod = u.pm % 9; const bool is_ctx = (pmod == 8); const int tb = pmod * 256;
        constexpr int nrope = (KIND == 2) ? 8 : 5;
        const bool isqk = u.pn < nrope, do_rope = isqk && !is_ctx;
        constexpr int NF = (KIND == 0) ? 32 : 16;
        const int axis = (KIND == 0) ? (wc >> 1) : (wc & 1), f0 = (KIND == 0) ? ((wc & 1) * 16 + 4 * fq) : 4 * fq;
        LAS float* S = ss + (ui & 1) * 2048;
        f32x4 g0 = (f32x4){1.f, 1.f, 1.f, 1.f}, g1 = g0;
        if constexpr (KIND == 0) {
#pragma unroll
            for (int ai = 0; ai < 2; ++ai)
#pragma unroll
                for (int m = 0; m < 4; ++m)
#pragma unroll
                    for (int bj = 0; bj < 2; ++bj) {
                        const f32x4 a = acc[ai][bj][m][0], b = acc[ai][bj][m][1];
                        float s = (a[0] * a[0] + a[1] * a[1]) + (a[2] * a[2] + a[3] * a[3]) + (b[0] * b[0] + b[1] * b[1]) + (b[2] * b[2] + b[3] * b[3]);
                        s += __shfl_xor(s, 16); s += __shfl_xor(s, 32);
                        if (fq == 0) S[(ai * 128 + wr * 64 + m * 16 + fr) * 8 + bj * 4 + wc] = s;
                    }
            asm volatile("s_waitcnt lgkmcnt(0)" ::: "memory"); __builtin_amdgcn_s_barrier(); asm volatile("" ::: "memory");
            if (isqk) { const float* gain = (u.pn < 4) ? qg : kg; g0 = *(const f32x4*)(gain + axis * 64 + f0); g1 = *(const f32x4*)(gain + axis * 64 + 32 + f0); }
        }
#pragma unroll
        for (int ai = 0; ai < 2; ++ai)
#pragma unroll
            for (int m = 0; m < 4; ++m) {
                const int rt = ai * 128 + wr * 64 + m * 16 + fr, t = tb + rt, pos = axis ? (t & 63) : (t >> 6);
                f32x4 cs = (f32x4){1.f, 1.f, 1.f, 1.f}, sn = (f32x4){0.f, 0.f, 0.f, 0.f};
                if (do_rope) { cs = *(const f32x4*)(rope + pos * NF + f0); sn = *(const f32x4*)(rope + 64 * NF + pos * NF + f0); }
                bf16_t* rowp = out + (size_t)(u.pm * 256 + rt) * ldo + u.pn * 256 + wc * 32 + 4 * fq;
#pragma unroll
                for (int bj = 0; bj < 2; ++bj) {
                    f32x4 x1 = acc[ai][bj][m][0], x2 = acc[ai][bj][m][1];
                    if constexpr (KIND == 0) { if (isqk) {
                        const f32x4 pp = *(const LAS f32x4*)(S + rt * 8 + bj * 4);
                        const float r = 1.0f / sqrtf(((pp[0] + pp[1]) + (pp[2] + pp[3])) * (1.0f / 128.0f) + RMS_EPS);
                        x1 = x1 * r * g0; x2 = x2 * r * g1; } }
                    const f32x4 o1 = x1 * cs - x2 * sn, o2 = x1 * sn + x2 * cs;
                    u32x2 w; w.x = cvt_pk_bf16(o1[0], o1[1]); w.y = cvt_pk_bf16(o1[2], o1[3]); *(u32x2*)(rowp + bj * 128) = w;
                    w.x = cvt_pk_bf16(o2[0], o2[1]); w.y = cvt_pk_bf16(o2[2], o2[3]); *(u32x2*)(rowp + bj * 128 + 16) = w;
                }
                asm volatile("" ::: "memory");
            }
    }
};
struct EpiWo {
    const float* X; float* Y; const float* mod;
    __device__ __forceinline__ void operator()(f32x4 (&acc)[2][2][4][2], const pg8::Unit& u, int, int wr, int wc, int fr, int fq) const {
        const int bb = (u.pm % 9 == 8) ? 8 : u.pm / 9; const float* g1 = mod + bb * 6144 + 2048;
        const int col0 = u.pn * 256 + wc * 32 + 4 * fq;
        f32x4 gv[2][2];
#pragma unroll
        for (int bj = 0; bj < 2; ++bj)
#pragma unroll
            for (int n = 0; n < 2; ++n) gv[bj][n] = *(const f32x4*)(g1 + col0 + bj * 128 + n * 16);
#pragma unroll
        for (int ai = 0; ai < 2; ++ai)
#pragma unroll
            for (int m = 0; m < 4; ++m) { const size_t off = (size_t)(u.pm * 256 + ai * 128 + wr * 64 + m * 16 + fr) * DM + col0;
#pragma unroll
                for (int bj = 0; bj < 2; ++bj)
#pragma unroll
                    for (int n = 0; n < 2; ++n) { const f32x4 xv = *(const f32x4*)(X + off + bj * 128 + n * 16); *(f32x4*)(Y + off + bj * 128 + n * 16) = xv * ALPHA + gv[bj][n] * acc[ai][bj][m][n]; }
                if (m & 1) asm volatile("" ::: "memory"); }
    }
};
struct EpiGU {
    bf16_t* HID;
    __device__ __forceinline__ void operator()(f32x4 (&acc)[2][2][4][2], const pg8::Unit& u, int, int wr, int wc, int fr, int fq) const {
#pragma unroll
        for (int ai = 0; ai < 2; ++ai)
#pragma unroll
            for (int m = 0; m < 4; ++m) { bf16_t* rowp = HID + (size_t)(u.pm * 256 + ai * 128 + wr * 64 + m * 16 + fr) * EFF + u.pn * 128 + wc * 32 + 4 * fq;
#pragma unroll
                for (int n = 0; n < 2; ++n) { const f32x4 a = acc[ai][0][m][n], b = acc[ai][1][m][n]; f32x4 h;
#pragma unroll
                    for (int j = 0; j < 4; ++j) h[j] = a[j] * __builtin_amdgcn_rcpf(1.0f + __expf(-a[j])) * b[j];
                    u32x2 w; w.x = cvt_pk_bf16(h[0], h[1]); w.y = cvt_pk_bf16(h[2], h[3]); *(u32x2*)(rowp + n * 16) = w; } }
    }
};
struct EpiDown {
    bf16_t* YS;
    __device__ __forceinline__ void operator()(f32x4 (&acc)[2][2][4][2], const pg8::Unit& u, int, int wr, int wc, int fr, int fq) const {
#pragma unroll
        for (int ai = 0; ai < 2; ++ai)
#pragma unroll
            for (int m = 0; m < 4; ++m) { bf16_t* rowp = YS + (size_t)(u.pm * 256 + ai * 128 + wr * 64 + m * 16 + fr) * DM + u.pn * 256 + wc * 32 + 4 * fq;
#pragma unroll
                for (int bj = 0; bj < 2; ++bj)
#pragma unroll
                    for (int n = 0; n < 2; ++n) { const f32x4 v = acc[ai][bj][m][n]; u32x2 w; w.x = cvt_pk_bf16(v[0], v[1]); w.y = cvt_pk_bf16(v[2], v[3]); *(u32x2*)(rowp + bj * 128 + n * 16) = w; } }
    }
};

namespace att {
#define SBAR() __builtin_amdgcn_sched_barrier(0)
__device__ __forceinline__ int crow(int r, int hi) { return (r & 3) + 8 * (r >> 2) + 4 * hi; }
template <int DQK> __device__ __forceinline__ int kswz(int row, int colB) { return row * (DQK * 2) + (colB ^ ((row & 7) << 4)); }
template <int NCB> __device__ __forceinline__ int v_st(int k, int c) { const int kk = (k & ~0xC) | ((k & 4) << 1) | ((k & 8) >> 1); return ((kk >> 3) * NCB + (c >> 5)) * 512 + ((kk & 7) * 32 + (c & 31)) * 2; }
__device__ __forceinline__ int v_rd_base(int lane) { return ((lane & 3) << 3) | (((lane >> 2) & 3) << 6) | (((lane >> 4) & 1) << 5) | (((lane >> 5) & 1) << 8); }
template <int NCB> constexpr int v_rd_off(int d0, int ks, int half) { return d0 * 512 + ks * (2 * NCB * 512) + half * (NCB * 512); }
template <int OFF> __device__ __forceinline__ s16x4 tr_read(int vb) { s16x4 r; asm volatile("ds_read_b64_tr_b16 %0, %1 offset:%2" : "=&v"(r) : "v"(vb), "i"(OFF) : "memory"); return r; }

template <int DQK> __device__ __forceinline__ void partialSM(f32x16& p0, f32x16& p1, float& m_reg, float& mn, float& alpha) {
    constexpr float SCALE = (DQK == 128) ? 0.088388347648318440f : 0.125f, C = SCALE * 1.4426950408889634f, THRS = 8.f / SCALE;
    float pmax = p0[0];
#pragma unroll
    for (int r = 1; r < 16; ++r) pmax = fmaxf(pmax, p0[r]);
#pragma unroll
    for (int r = 0; r < 16; ++r) pmax = fmaxf(pmax, p1[r]);
    { auto rr = __builtin_amdgcn_permlane32_swap(__float_as_uint(pmax), __float_as_uint(pmax), false, false); pmax = fmaxf(__uint_as_float(rr[0]), __uint_as_float(rr[1])); }
    if (__builtin_expect(__all(pmax - m_reg <= THRS), 1)) { mn = m_reg; alpha = 1.f; }
    else { mn = fmaxf(m_reg, pmax); alpha = __builtin_amdgcn_exp2f((m_reg - mn) * C); m_reg = mn; }
    const float mnC = -mn * C;
#pragma unroll
    for (int r = 0; r < 16; ++r) p0[r] = fmaf(p0[r], C, mnC);
#pragma unroll
    for (int r = 0; r < 16; ++r) p1[r] = fmaf(p1[r], C, mnC);
#pragma unroll
    for (int r = 0; r < 16; ++r) p0[r] = __builtin_amdgcn_exp2f(p0[r]);
}
__device__ __forceinline__ void finishSM(f32x16& p0, f32x16& p1, float alpha, float& l_reg, bf16x8& pa0, bf16x8& pa1, bf16x8& pa2, bf16x8& pa3) {
#pragma unroll
    for (int r = 0; r < 16; ++r) p1[r] = __builtin_amdgcn_exp2f(p1[r]);
    float ps = 0;
#pragma unroll
    for (int r = 0; r < 16; ++r) ps += p0[r];
#pragma unroll
    for (int r = 0; r < 16; ++r) ps += p1[r];
    { auto rr = __builtin_amdgcn_permlane32_swap(__float_as_uint(ps), __float_as_uint(ps), false, false); ps = __uint_as_float(rr[0]) + __uint_as_float(rr[1]); }
    l_reg = l_reg * alpha + ps;
#define PK4(P, BASE, OUT) do { unsigned a0 = cvt_pk_bf16(P[BASE + 0], P[BASE + 1]), a1 = cvt_pk_bf16(P[BASE + 2], P[BASE + 3]);   \
    unsigned b0 = cvt_pk_bf16(P[BASE + 4], P[BASE + 5]), b1 = cvt_pk_bf16(P[BASE + 6], P[BASE + 7]);                              \
    auto r0 = __builtin_amdgcn_permlane32_swap(a0, b0, false, false); auto r1 = __builtin_amdgcn_permlane32_swap(a1, b1, false, false); \
    u32x4 w = {r0[0], r1[0], r0[1], r1[1]}; OUT = __builtin_bit_cast(bf16x8, w); } while (0)
    PK4(p0, 0, pa0); PK4(p0, 8, pa1); PK4(p1, 0, pa2); PK4(p1, 8, pa3);
#undef PK4
}
template <int DQK> __device__ __forceinline__ void qkt(f32x16& p0, f32x16& p1, const LAS char* Ks, const bf16x8* qr, int r32, int hi) {
    p0 = f32x16{}; p1 = f32x16{};
#pragma unroll
    for (int d0 = 0; d0 < DQK / 16; ++d0) { const int cb = (d0 * 16 + hi * 8) * 2;
        const bf16x8 b0 = *(const LAS bf16x8*)(Ks + kswz<DQK>(r32, cb));
        const bf16x8 b1 = *(const LAS bf16x8*)(Ks + kswz<DQK>(32 + r32, cb));
        p0 = __builtin_amdgcn_mfma_f32_32x32x16_bf16(b0, qr[d0], p0, 0, 0, 0);
        p1 = __builtin_amdgcn_mfma_f32_32x32x16_bf16(b1, qr[d0], p1, 0, 0, 0); }
}
template <int NCB, int D0> __device__ __forceinline__ void pv_one(f32x16& od, int vb, bf16x8 pa0, bf16x8 pa1, bf16x8 pa2, bf16x8 pa3) {
    const s16x4 l0 = tr_read<v_rd_off<NCB>(D0, 0, 0)>(vb), h0 = tr_read<v_rd_off<NCB>(D0, 0, 1)>(vb), l1 = tr_read<v_rd_off<NCB>(D0, 1, 0)>(vb), h1 = tr_read<v_rd_off<NCB>(D0, 1, 1)>(vb);
    const s16x4 l2 = tr_read<v_rd_off<NCB>(D0, 2, 0)>(vb), h2 = tr_read<v_rd_off<NCB>(D0, 2, 1)>(vb), l3 = tr_read<v_rd_off<NCB>(D0, 3, 0)>(vb), h3 = tr_read<v_rd_off<NCB>(D0, 3, 1)>(vb);
    asm volatile("s_waitcnt lgkmcnt(0)" ::: "memory"); SBAR();
#define PK(L, H) (bf16x8){L[0], L[1], L[2], L[3], H[0], H[1], H[2], H[3]}
    od = __builtin_amdgcn_mfma_f32_32x32x16_bf16(pa0, PK(l0, h0), od, 0, 0, 0);
    od = __builtin_amdgcn_mfma_f32_32x32x16_bf16(pa1, PK(l1, h1), od, 0, 0, 0);
    od = __builtin_amdgcn_mfma_f32_32x32x16_bf16(pa2, PK(l2, h2), od, 0, 0, 0);
    od = __builtin_amdgcn_mfma_f32_32x32x16_bf16(pa3, PK(l3, h3), od, 0, 0, 0);
#undef PK
}
template <int DV> __device__ __forceinline__ void pv_all(f32x16 (&o)[DV / 32], int vb, bf16x8 pa0, bf16x8 pa1, bf16x8 pa2, bf16x8 pa3) {
    constexpr int NCB = DV / 32;
    pv_one<NCB, 0>(o[0], vb, pa0, pa1, pa2, pa3); pv_one<NCB, 1>(o[1], vb, pa0, pa1, pa2, pa3);
    if constexpr (DV == 128) { pv_one<NCB, 2>(o[2], vb, pa0, pa1, pa2, pa3); pv_one<NCB, 3>(o[3], vb, pa0, pa1, pa2, pa3); }
}

template <int DQK, int DV, bool WIN>
__device__ __forceinline__ void attn_core(const bf16_t* __restrict__ Qb, const int ldq, const bf16_t* __restrict__ Kh, const bf16_t* __restrict__ Vh, const int ldk,
                                          const int NT, const int nfirst, const int base1, const int base2, const int qpos0,
                                          LAS char* lds, f32x16 (&o)[DV / 32], float& m_out, float& l_out) {
    constexpr int SHM_V = 64 * DV * 2, SHM_K = 64 * DQK * 2, KP = DQK / 64, VP = DV / 64, NCB = DV / 32, ND = DQK / 16;
    int tid = threadIdx.x; asm volatile("" : "+v"(tid));
    const int wid = tid >> 6, lane = tid & 63, r32 = lane & 31, hi = lane >> 5;
    LAS char* V_lds = lds; LAS char* K_lds = lds + 2 * SHM_V;
    LAS float* ws = (LAS float*)(lds + 2 * SHM_V + 2 * SHM_K) + wid * 64; LAS float* al_l = ws + 32;
    float m_reg = -1e30f, l_reg = 0.f;
#pragma unroll
    for (int d = 0; d < DV / 32; ++d) o[d] = f32x16{};
    bf16x8 qr[ND];
    const bf16_t* Qw = Qb + (size_t)(wid * 32 + r32) * ldq + hi * 8;
#pragma unroll
    for (int d0 = 0; d0 < ND; ++d0) qr[d0] = *(const bf16x8*)(Qw + d0 * 16);
    const int ksr = (KP == 2) ? (tid >> 4) : (tid >> 3), ksc = (KP == 2) ? (tid & 15) * 8 : (tid & 7) * 8;
    const int vsr = (VP == 2) ? (tid >> 4) : (tid >> 3), vsc = (VP == 2) ? (tid & 15) * 8 : (tid & 7) * 8;
    const int kst0 = kswz<DQK>(ksr, ksc * 2), kst1 = kswz<DQK>(32 + ksr, ksc * 2), vst0 = v_st<NCB>(vsr, vsc), vst1 = v_st<NCB>(32 + vsr, vsc);
    const int vb0 = (int)(unsigned)(uintptr_t)V_lds + v_rd_base(lane);
    struct { bf16x8 vs0, vs1, ks0, ks1; } sr_[2];
#define KB(j) (((j) < nfirst) ? base1 + 64 * (j) : base2 + 64 * ((j) - nfirst))
#define SLOAD(i, j) do { const int kb_ = KB(j); sr_[i].ks0 = *(const bf16x8*)(&Kh[(size_t)(kb_ + ksr) * ldk + ksc]); if (KP == 2) sr_[i].ks1 = *(const bf16x8*)(&Kh[(size_t)(kb_ + 32 + ksr) * ldk + ksc]); \
    sr_[i].vs0 = *(const bf16x8*)(&Vh[(size_t)(kb_ + vsr) * ldk + vsc]); if (VP == 2) sr_[i].vs1 = *(const bf16x8*)(&Vh[(size_t)(kb_ + 32 + vsr) * ldk + vsc]); } while (0)
#define SWRITE(b, i) do { *(LAS bf16x8*)(V_lds + (b) * SHM_V + vst0) = sr_[i].vs0; if (VP == 2) *(LAS bf16x8*)(V_lds + (b) * SHM_V + vst1) = sr_[i].vs1; \
    *(LAS bf16x8*)(K_lds + (b) * SHM_K + kst0) = sr_[i].ks0; if (KP == 2) *(LAS bf16x8*)(K_lds + (b) * SHM_K + kst1) = sr_[i].ks1; } while (0)
#define RESC(a) do { if (__any((a) < 1.f)) { if (hi == 0) al_l[r32] = (a); asm volatile("s_waitcnt lgkmcnt(0)" ::: "memory"); \
    _Pragma("unroll") for (int d = 0; d < DV / 32; ++d) _Pragma("unroll") for (int r = 0; r < 16; ++r) o[d][r] *= al_l[crow(r, hi)]; } } while (0)
#define MASK(P0, P1, j) do { if (WIN && (j) >= nfirst) { const int dq_ = base2 + 64 * ((j) - nfirst) - (qpos0 + wid * 32 + r32); \
    _Pragma("unroll") for (int r = 0; r < 16; ++r) { const int dd_ = dq_ + crow(r, hi); if ((unsigned)(dd_ + 128) > 256u) P0[r] = -1e30f; if ((unsigned)(dd_ + 160) > 256u) P1[r] = -1e30f; } } } while (0)
    f32x16 pA0, pA1, pB0, pB1; float mnA, mnB, alA, alB; bf16x8 pa0, pa1, pa2, pa3;
    SLOAD(0, 0); asm volatile("s_waitcnt vmcnt(0)" ::: "memory"); SWRITE(0, 0); __syncthreads();
    qkt<DQK>(pA0, pA1, K_lds, qr, r32, hi); MASK(pA0, pA1, 0); partialSM<DQK>(pA0, pA1, m_reg, mnA, alA);
    SLOAD(1, 1); if (2 < NT) SLOAD(0, 2);
    SWRITE(1, 1); __syncthreads();
    for (int j = 1; j + 1 < NT; j += 2) {
        SBAR(); qkt<DQK>(pB0, pB1, K_lds + SHM_K, qr, r32, hi); MASK(pB0, pB1, j);
        finishSM(pA0, pA1, alA, l_reg, pa0, pa1, pa2, pa3); SBAR();
        SLOAD(1, j + 2); SBAR();
        pv_all<DV>(o, vb0, pa0, pa1, pa2, pa3); partialSM<DQK>(pB0, pB1, m_reg, mnB, alB);
        __syncthreads(); SWRITE(0, 0);
        RESC(alB); __syncthreads();
        SBAR(); qkt<DQK>(pA0, pA1, K_lds, qr, r32, hi); MASK(pA0, pA1, j + 1);
        finishSM(pB0, pB1, alB, l_reg, pa0, pa1, pa2, pa3); SBAR();
        if (j + 3 < NT) SLOAD(0, j + 3); SBAR();
        pv_all<DV>(o, vb0 + SHM_V, pa0, pa1, pa2, pa3); partialSM<DQK>(pA0, pA1, m_reg, mnA, alA);
        __syncthreads(); SWRITE(1, 1);
        RESC(alA); __syncthreads();
    }
    SBAR(); qkt<DQK>(pB0, pB1, K_lds + SHM_K, qr, r32, hi); MASK(pB0, pB1, NT - 1);
    finishSM(pA0, pA1, alA, l_reg, pa0, pa1, pa2, pa3); SBAR();
    pv_all<DV>(o, vb0, pa0, pa1, pa2, pa3); partialSM<DQK>(pB0, pB1, m_reg, mnB, alB);
    __syncthreads(); RESC(alB);
    finishSM(pB0, pB1, alB, l_reg, pa0, pa1, pa2, pa3); SBAR();
    pv_all<DV>(o, vb0 + SHM_V, pa0, pa1, pa2, pa3);
    m_out = m_reg; l_out = l_reg;
#undef KB
#undef SLOAD
#undef SWRITE
#undef RESC
#undef MASK
}
__device__ __forceinline__ void row_bcast(LAS float* ws, float v, int r32, int hi, float (&out)[16]) {
    if (hi == 0) ws[r32] = v; asm volatile("s_waitcnt lgkmcnt(0)" ::: "memory");
#pragma unroll
    for (int r = 0; r < 16; ++r) out[r] = ws[crow(r, hi)];
    asm volatile("s_waitcnt lgkmcnt(0)" ::: "memory");
}
#undef SBAR
}

constexpr int NPHASE = 3 + 7 * DEPTH;
struct Args { const float* in[29]; float* out; unsigned char* ws; int ph_lo, ph_hi; };

__device__ __forceinline__ void sincos_small(double x, double& s, double& c) {
    const double k = __builtin_rint(x * 0.6366197723675814);
    const double r = (x - k * 1.5707963267341256) - k * 6.077100506506192e-11;
    const double r2 = r * r;
    double sp = 1.0 / 6402373705728000.0, cp = 1.0 / 355687428096000.0;
    double cs = -sp; cs = cs * r2 + 1.0 / 20922789888000.0; cs = cs * r2 - 1.0 / 87178291200.0; cs = cs * r2 + 1.0 / 479001600.0; cs = cs * r2 - 1.0 / 3628800.0;
    cs = cs * r2 + 1.0 / 40320.0; cs = cs * r2 - 1.0 / 720.0; cs = cs * r2 + 1.0 / 24.0; cs = cs * r2 - 0.5; cs = cs * r2 + 1.0;
    double sn = cp; sn = sn * r2 - 1.0 / 1307674368000.0; sn = sn * r2 + 1.0 / 6227020800.0; sn = sn * r2 - 1.0 / 39916800.0; sn = sn * r2 + 1.0 / 362880.0;
    sn = sn * r2 - 1.0 / 5040.0; sn = sn * r2 + 1.0 / 120.0; sn = sn * r2 - 1.0 / 6.0; sn = sn * r2 + 1.0; sn = sn * r;
    const int q = ((int)k) & 3;
    s = (q == 0) ? sn : (q == 1) ? cs : (q == 2) ? -sn : -cs;
    c = (q == 0) ? cs : (q == 1) ? -sn : (q == 2) ? -cs : sn;
}

__device__ __forceinline__ void transpose_tile(const float* __restrict__ src, int N, int k0, int n0, bf16_t* __restrict__ dst, int ldk, int drow0, bool perm, LAS float* scr, int lane) {
    const int rsub = lane >> 4, c4 = (lane & 15) * 4;
    f32x4 v[16];
#pragma unroll
    for (int i = 0; i < 16; ++i) v[i] = *(const f32x4*)(src + (size_t)(k0 + 4 * i + rsub) * N + n0 + c4);
#pragma unroll
    for (int i = 0; i < 16; ++i) { LAS float* p = scr + (4 * i + rsub) * 65 + c4; p[0] = v[i][0]; p[1] = v[i][1]; p[2] = v[i][2]; p[3] = v[i][3]; }
    asm volatile("s_waitcnt lgkmcnt(0)" ::: "memory");
    const int c = lane & 7, nl = lane >> 3;
#pragma unroll
    for (int j = 0; j < 8; ++j) { const int n = nl + 8 * j; const LAS float* s = scr + (8 * c) * 65 + n;
        u32x4 o; o.x = cvt_pk_bf16(s[0], s[65]); o.y = cvt_pk_bf16(s[2 * 65], s[3 * 65]); o.z = cvt_pk_bf16(s[4 * 65], s[5 * 65]); o.w = cvt_pk_bf16(s[6 * 65], s[7 * 65]);
        const int nn = perm ? ((n & 15) | ((n & 16) << 1) | ((n & 32) >> 1)) : n;
        *(u32x4*)(dst + (size_t)(drow0 + nn) * ldk + k0 + 8 * c) = o; }
    asm volatile("s_waitcnt lgkmcnt(0)" ::: "memory");
}

__global__ void __launch_bounds__(512, 2) fwd(Args args) {
    extern __shared__ __attribute__((aligned(16))) unsigned char lds_raw[];
    LAS unsigned char* lds = (LAS unsigned char*)lds_raw;
    volatile LAS unsigned* MISC = (volatile LAS unsigned*)(lds + MISC_OFF);
    LAS unsigned char* ring = lds + RING_OFF;
    LAS int* tab = (LAS int*)(lds + TAB_OFF);
    const int wave = __builtin_amdgcn_readfirstlane((int)threadIdx.x >> 6);
#define PHASE_TID() int tid = threadIdx.x; asm volatile("" : "+v"(tid)); const int lane = tid & 63; (void)lane
    const int G = gridDim.x, bx = blockIdx.x;
    const int vcu = (G % 8 == 0) ? (bx % 8) * (G / 8) + bx / 8 : bx;
    const int gw = bx * 8 + wave, NGW = G * 8, NGT = G * 512;
    unsigned char* ws = args.ws;
    unsigned* ctl = (unsigned*)(ws + WS_CTL);
#define WSP(T, off) ((T*)(opaque(ws) + (off)))
    if (threadIdx.x < 128) ((LAS unsigned*)(lds + MISC_OFF))[threadIdx.x] = 0u;
    __syncthreads();
    XcdBarrier bar; bar.bar = ctl + CW_BAR; bar.x = 0; bar.st = nullptr;
    if (MK_N_LAUNCHES == 1) bar = xcd_barrier_post(ctl + CW_BAR, MISC + 8);
    const int lo = args.ph_lo, hi = args.ph_hi;
#ifndef PHMASK
#define PHMASK 0x3ff
#endif
#define EN(bit) ((PHMASK >> (bit)) & 1)
#ifndef DUPMASK
#define DUPMASK 0
#endif
#define REP(k) _Pragma("unroll 1") for (int rep_ = 0; rep_ < (((DUPMASK >> (k)) & 1) ? 2 : 1); ++rep_)
#define IN(k) (lo <= (k) && (k) < hi)
#define SEAM(k) do { if (MK_N_LAUNCHES == 1) { if ((k) + 1 < hi) { xcd_barrier(bar); if ((DUPMASK >> 11) & 1) xcd_barrier(bar); } } } while (0)

    if (EN(0) && IN(0)) { REP(0) {
        PHASE_TID(); const int gt = bx * 512 + tid;
        const float* cvec = args.in[1]; const float* cctx = args.in[3]; const float* w_mod = args.in[4];
        float* PART = WSP(float, WS_PART); bf16_t* WQKV = WSP(bf16_t, WS_WQKV); bf16_t* WO = WSP(bf16_t, WS_WO); bf16_t* WGU = WSP(bf16_t, WS_WGU); bf16_t* WD = WSP(bf16_t, WS_WD);
        float* ROPE128 = WSP(float, WS_ROPE); float* ROPE64 = WSP(float, WS_ROPE + 16384); float* WR = WSP(float, WS_WR);
        LAS float* SL = (LAS float*)ring;
        for (int i = tid; i < 9 * 1024; i += 512) { const int bb = i >> 10, k = i & 1023; const float c = bb < 8 ? cvec[bb * 1024 + k] : cctx[k]; SL[i] = c / (1.0f + expf(-c)); }
        __syncthreads();
        for (int it = gw; it < 4 * 24 * KSPLIT; it += NGW) {
            const int ks = it % KSPLIT, cb = (it / KSPLIT) % 24, l = it / (KSPLIT * 24);
            f32x4 acc[9];
#pragma unroll
            for (int bb = 0; bb < 9; ++bb) acc[bb] = (f32x4){0.f, 0.f, 0.f, 0.f};
            const float* w = w_mod + ((size_t)l * 1024 + ks * 64) * 6144 + cb * 256 + 4 * lane;
#pragma unroll 8
            for (int kk = 0; kk < 64; ++kk) { const f32x4 wv = *(const f32x4*)(w + (size_t)kk * 6144);
#pragma unroll
                for (int bb = 0; bb < 9; ++bb) acc[bb] += SL[bb * 1024 + ks * 64 + kk] * wv; }
#pragma unroll
            for (int bb = 0; bb < 9; ++bb) *(f32x4*)(PART + (((size_t)ks * 4 + l) * 9 + bb) * 6144 + cb * 256 + 4 * lane) = acc[bb];
        }
        __syncthreads();
        LAS float* scr = (LAS float*)ring + wave * (64 * 65);
        constexpr int T_QKV = 1920, T_WO = 1024, T_GU = 32768, T_DN = 16384, T_ALL = T_QKV + T_WO + T_GU + T_DN;
        for (int id0 = gw; id0 < T_ALL; id0 += NGW) {
            int id = id0;
            if (id < T_QKV) {
                int l, r; if (id < 384) { l = 0; r = id; } else if (id < 768) { l = 1; r = id - 384; } else if (id < 1536) { l = 2; r = id - 768; } else { l = 3; r = id - 1536; }
                const int N = (l == 2) ? 3072 : 1536, nbN = N / 64, kb = r / nbN, nb = r % nbN;
                const float* src = (l == 0) ? args.in[8] : (l == 1) ? args.in[12] : (l == 2) ? args.in[15] : args.in[8] + (size_t)1024 * 1536;
                const int drow = (l == 0) ? 0 : (l == 1) ? 1536 : (l == 2) ? 3072 : 6144;
                const bool perm = (l == 0 || l == 3) && (nb * 64 < 1280);
                transpose_tile(src, N, kb * 64, nb * 64, WQKV, 1024, drow + nb * 64, perm, scr, lane);
            } else if ((id -= T_QKV) < T_WO) {
                const int l = id >> 8, r = id & 255, kb = r >> 4, nb = r & 15;
                const float* src = (l == 0) ? args.in[11] : (l == 1) ? args.in[14] : (l == 2) ? args.in[21] : args.in[11] + (size_t)1024 * 1024;
                transpose_tile(src, 1024, kb * 64, nb * 64, WO + (size_t)l * 1024 * 1024, 1024, nb * 64, false, scr, lane);
            } else if ((id -= T_WO) < T_GU) {
                const int which = id >> 14, r = id & 16383, lge = r >> 7, rr = r & 127, kb = rr >> 3, nb = rr & 7;
                const float* src = (which ? args.in[27] : args.in[26]) + (size_t)lge * 1024 * 512;
                const int n0 = nb * 64, drow = lge * 1024 + (n0 >> 7) * 256 + which * 128 + (n0 & 127);
                transpose_tile(src, 512, kb * 64, n0, WGU, 1024, drow, false, scr, lane);
            } else {
                id -= T_GU; const int lge = id >> 7, rr = id & 127, kb = rr >> 4, nb = rr & 15;
                const float* src = args.in[28] + (size_t)lge * 512 * 1024;
                transpose_tile(src, 1024, kb * 64, nb * 64, WD, 512, lge * 1024 + nb * 64, false, scr, lane);
            }
        }
        for (int i = gt; i < 64 * 32 + 64 * 16; i += NGT) {
            const bool big = i < 2048; const int ii = big ? i : i - 2048, NF = big ? 32 : 16, pos = ii / NF, f = ii % NF;
            const double base = big ? 0.7498942093324559 : 0.5623413251903491; double inv = 1.0;
            for (int q = 0; q < f; ++q) inv *= base;
            const float ang = (float)pos * (float)inv; double s, c; sincos_small((double)ang, s, c);
            float* Tt = big ? ROPE128 : ROPE64; Tt[ii] = (float)c; Tt[64 * NF + ii] = (float)s;
        }
        { const float* wg = args.in[22]; const float* we = args.in[24];
          for (int i = gt; i < 4 * 36 * 1024; i += NGT) { const int l = i / (36 * 1024), e = (i >> 10) % 36, c = i & 1023;
              WR[i] = (e < 4) ? wg[((size_t)l * 1024 + c) * 4 + e] : we[((size_t)l * 1024 + c) * 32 + (e - 4)]; } }
        __syncthreads(); }
        SEAM(0);
    }
    if (EN(1) && IN(1)) {
        PHASE_TID(); const int gt = bx * 512 + tid;
        const float* b_mod = args.in[5]; float* PART = WSP(float, WS_PART); float* MOD = WSP(float, WS_MOD);
        for (int i = gt; i < 4 * 9 * 6144; i += NGT) { const int l = i / 55296, bbj = i % 55296, j = bbj % 6144; float s = b_mod[l * 6144 + j];
#pragma unroll
            for (int ks = 0; ks < KSPLIT; ++ks) s += PART[((size_t)ks * 4 + l) * 55296 + bbj];
            MOD[i] = s; }
        SEAM(1);
    }
    if (EN(1) && IN(2)) { REP(1) {
        PHASE_TID();
        const float* xin = args.in[0]; const float* cin = args.in[2]; float* MOD = WSP(float, WS_MOD); float* X = WSP(float, WS_X); bf16_t* HB = WSP(bf16_t, WS_HB);
        for (int row = gw; row < MROWS; row += NGW) {
            const int b = row / TPB, t = row % TPB; const bool is_ctx = t >= SEQ; const int bb = is_ctx ? 8 : b;
            const float* src = is_ctx ? cin + ((size_t)b * CTXL + (t - SEQ)) * DM : xin + ((size_t)b * SEQ + t) * DM;
            const float* mv = MOD + (size_t)bb * 6144;
#pragma unroll
            for (int j = 0; j < 4; ++j) { const int c = 4 * lane + 256 * j; const f32x4 v = *(const f32x4*)(src + c);
                *(f32x4*)(X + (size_t)row * DM + c) = v;
                const f32x4 sh = *(const f32x4*)(mv + c), sc = *(const f32x4*)(mv + 1024 + c); const f32x4 h = v * (sc + 1.0f) + sh;
                u32x2 w; w.x = cvt_pk_bf16(h[0], h[1]); w.y = cvt_pk_bf16(h[2], h[3]); *(u32x2*)(HB + (size_t)row * DM + c) = w; }
        } }
        SEAM(2);
    }
#pragma unroll 1
    for (int l = 0; l < DEPTH; ++l) {
        const int kind = l % 3, P = 3 + 7 * l; const bool lastl = (l == DEPTH - 1);
#define MODL (WSP(float, WS_MOD) + (size_t)l * 9 * 6144)
        const int wq_row = (l == 0) ? 0 : (l == 1) ? 1536 : (l == 2) ? 3072 : 6144;
        const int NQ = (kind == 2) ? 3072 : 1536;
#define CNTL ((unsigned*)opaque(ws) + CW_CNT + l * 2048)
        if (EN(2) && IN(P + 0)) { REP(2) {
            DenseSched S; S.init(WSP(bf16_t, WS_HB), WSP(bf16_t, WS_WQKV) + (size_t)wq_row * 1024, 1024, 72, NQ / 256, G, bx, 0); bf16_t* qkv_o = WSP(bf16_t, WS_QKV);
            if (EN(7) && kind == 0) { EpiQKV<0> E{qkv_o, NQ, WSP(float, WS_ROPE), args.in[9] + (l / 3) * 128, args.in[10] + (l / 3) * 128, (LAS float*)(lds + SS_OFF)}; pg8::gemm_phase(ring, 1024, S, E); }
            else if (EN(8) && kind == 1) { EpiQKV<1> E{qkv_o, NQ, WSP(float, WS_ROPE + 16384), nullptr, nullptr, nullptr}; pg8::gemm_phase(ring, 1024, S, E); }
            else if (EN(9) && kind == 2) { EpiQKV<2> E{qkv_o, NQ, WSP(float, WS_ROPE + 16384), nullptr, nullptr, nullptr}; pg8::gemm_phase(ring, 1024, S, E); } }
            SEAM(P + 0);
        }
        if (EN(3) && IN(P + 1)) {
            LAS char* alds = (LAS char*)ring; bf16_t* QKV = WSP(bf16_t, WS_QKV); bf16_t* OB = WSP(bf16_t, WS_O); float* STASH = WSP(float, WS_STASH) + (size_t)bx * (64 * 512);
            PHASE_TID(); const int r32 = lane & 31, hh = lane >> 5;
            if (EN(7) && kind == 0) { REP(3) {
                LAS float* wsf = (LAS float*)(alds + 4 * 16384) + wave * 64;
                const int nlat = 512, nall = nlat + (lastl ? 0 : 64);
                for (int u = vcu; u < nall; u += G) {
                    int b, hq, q0, NT, base1;
                    if (u < nlat) { const int qb = u & 7, g = (u >> 3) & 3, kv = (u >> 5) & 1; b = u >> 6; hq = kv * 4 + g; q0 = qb * 256; NT = 36; base1 = 0; }
                    else { const int uc = u - nlat; hq = uc & 7; b = uc >> 3; q0 = 2048; NT = 4; base1 = 2048; }
                    const int kv = hq >> 2; const size_t rb = (size_t)b * TPB;
                    f32x16 o[4]; float m, lsum;
                    att::attn_core<128, 128, false>(opaque(QKV) + (rb + q0) * 1536 + hq * 128, 1536, opaque(QKV) + rb * 1536 + 1024 + kv * 128, opaque(QKV) + rb * 1536 + 1280 + kv * 128, 1536, NT, NT, base1, 0, 0, alds, o, m, lsum);
                    float rl[16]; att::row_bcast(wsf, 1.0f / lsum, r32, hh, rl);
                    bf16_t* Ow = opaque(OB) + (rb + q0 + wave * 32) * DM + hq * 128 + r32;
#pragma unroll
                    for (int r = 0; r < 16; ++r) { const int orow = att::crow(r, hh);
#pragma unroll
                        for (int d0 = 0; d0 < 4; ++d0) Ow[(size_t)orow * DM + d0 * 32] = (bf16_t)(cvt_pk_bf16(o[d0][r] * rl[r], 0.f) & 0xffffu); }
                }
            } } else if (EN(8) && kind == 1) { REP(4) {
                LAS float* wsf = (LAS float*)(alds + 4 * 8192) + wave * 64;
                const float* sink = opaque(args.in[13]);
                const int nlat = 1024, nall = nlat + (lastl ? 0 : 128);
                for (int u = vcu; u < nall; u += G) {
                    int b, hq, q0, NT, base2;
                    if (u < nlat) { const int qb = u & 7, g = (u >> 3) & 3, kv = (u >> 5) & 3; b = u >> 7; hq = kv * 4 + g; q0 = qb * 256;
                        const int klo = (q0 - 128) < 0 ? 0 : q0 - 128, khi = (q0 + 384) > SEQ ? SEQ : q0 + 384; base2 = klo; NT = 4 + (khi - klo) / 64; }
                    else { const int uc = u - nlat; hq = uc & 15; b = uc >> 4; q0 = 2048; NT = 4; base2 = 0; }
                    const int kv = hq >> 2; const size_t rb = (size_t)b * TPB;
                    f32x16 o[2]; float m, lsum;
                    att::attn_core<64, 64, true>(opaque(QKV) + (rb + q0) * 1536 + hq * 64, 1536, opaque(QKV) + rb * 1536 + 1024 + kv * 64, opaque(QKV) + rb * 1536 + 1280 + kv * 64, 1536, NT, 4, 2048, base2, q0, alds, o, m, lsum);
                    lsum += exp2f(sink[hq] * 1.4426950408889634f - m * (0.125f * 1.4426950408889634f));
                    float rl[16]; att::row_bcast(wsf, 1.0f / lsum, r32, hh, rl);
                    bf16_t* Ow = opaque(OB) + (rb + q0 + wave * 32) * DM + hq * 64 + r32;
#pragma unroll
                    for (int r = 0; r < 16; ++r) { const int orow = att::crow(r, hh);
#pragma unroll
                        for (int d0 = 0; d0 < 2; ++d0) Ow[(size_t)orow * DM + d0 * 32] = (bf16_t)(cvt_pk_bf16(o[d0][r] * rl[r], 0.f) & 0xffffu); }
                }
            } } else if (EN(9) && kind == 2) { REP(5) {
                LAS float* wsf = (LAS float*)(alds + 2 * 16384 + 2 * 8192) + wave * 64;
                const float lam = expf(wave_sum(opaque(args.in[16])[lane] * opaque(args.in[17])[lane])) - expf(wave_sum(opaque(args.in[18])[lane] * opaque(args.in[19])[lane])) + LAM_INIT_C;
                const float* sg = opaque(args.in[20]);
                const int nlat = 512, nall = nlat + (lastl ? 0 : 64);
                for (int u = vcu; u < nall; u += G) {
                    int b, h, q0, NT, base1;
                    if (u < nlat) { const int qb = u & 7; h = (u >> 3) & 7; b = u >> 6; q0 = qb * 256; NT = 36; base1 = 0; }
                    else { const int uc = u - nlat; h = uc & 7; b = uc >> 3; q0 = 2048; NT = 4; base1 = 2048; }
                    const size_t rb = (size_t)b * TPB;
#pragma unroll 1
                    for (int mp = 0; mp < 2; ++mp) {
                        f32x16 o[4]; float m, lsum; float rl[16];
                        att::attn_core<64, 128, false>(opaque(QKV) + (rb + q0) * 3072 + h * 128 + mp * 64, 3072, opaque(QKV) + rb * 3072 + 1024 + h * 128 + mp * 64, opaque(QKV) + rb * 3072 + 2048 + h * 128, 3072, NT, NT, base1, 0, 0, alds, o, m, lsum);
                        att::row_bcast(wsf, 1.0f / lsum, r32, hh, rl);
                        float* st = opaque(STASH) + tid;
                        if (mp == 0) {
#pragma unroll
                            for (int d0 = 0; d0 < 4; ++d0)
#pragma unroll
                                for (int r = 0; r < 16; ++r) st[(d0 * 16 + r) * 512] = o[d0][r] * rl[r];
                        } else {
                            const f32x4 gv = (f32x4){sg[r32], sg[32 + r32], sg[64 + r32], sg[96 + r32]};
                            bf16_t* Ow = opaque(OB) + (rb + q0 + wave * 32) * DM + h * 128 + r32;
#pragma unroll
                            for (int r = 0; r < 16; ++r) { float v[4]; float ss = 0.f;
#pragma unroll
                                for (int d0 = 0; d0 < 4; ++d0) { v[d0] = st[(d0 * 16 + r) * 512] - lam * (o[d0][r] * rl[r]); ss += v[d0] * v[d0]; }
                                ss += __shfl_xor(ss, 1); ss += __shfl_xor(ss, 2); ss += __shfl_xor(ss, 4); ss += __shfl_xor(ss, 8); ss += __shfl_xor(ss, 16);
                                const float rinv = (1.0f - LAM_INIT_C) / sqrtf(ss * (1.0f / 128.0f) + RMS_EPS); const int orow = att::crow(r, hh);
#pragma unroll
                                for (int d0 = 0; d0 < 4; ++d0) Ow[(size_t)orow * DM + d0 * 32] = (bf16_t)(cvt_pk_bf16(v[d0] * rinv * gv[d0], 0.f) & 0xffffu);
                                if ((r & 3) == 3) asm volatile("" ::: "memory"); }
                        }
                    }
                }
            } }
            SEAM(P + 1);
        }
        if (EN(4) && IN(P + 2)) { REP(6) {
            DenseSched S; S.init(WSP(bf16_t, WS_O), WSP(bf16_t, WS_WO) + (size_t)l * 1024 * 1024, 1024, lastl ? 64 : 72, 4, G, bx, lastl ? 1 : 0);
            EpiWo E{WSP(float, WS_X), WSP(float, WS_Y), MODL};
            pg8::gemm_phase(ring, 1024, S, E); }
            SEAM(P + 2);
        }
        if (EN(5) && IN(P + 3)) { REP(9) {
            const float* lg = opaque(args.in[6] + (size_t)(l * 2 + 0) * 1024); const float* lb = opaque(args.in[7] + (size_t)(l * 2 + 0) * 1024);
            const float* wr = WSP(float, WS_WR) + (size_t)l * 36 * 1024; const float* bg = opaque(args.in[23] + l * 4); const float* be = opaque(args.in[25] + l * 32);
            float* X = WSP(float, WS_X); float* Y = WSP(float, WS_Y); bf16_t* HB = WSP(bf16_t, WS_HB); const float* modl = MODL; u32x4* TOK = WSP(u32x4, WS_TOK); int* LIST = WSP(int, WS_LIST); unsigned* cnt = CNTL;
            PHASE_TID();
            LAS unsigned* RI = (LAS unsigned*)ring; LAS unsigned* lc = RI + 128 * 8; LAS unsigned* gb = lc + 32;
            __syncthreads();
            if (tid < 128) RI[tid * 8] = 0xffffffffu; if (tid < 32) lc[tid] = 0u;
            __syncthreads();
            constexpr int RB = 3;
            int nslot = wave * 16;
            for (int r0 = gw; r0 < MROWS; r0 += NGW * RB, nslot += RB) {
                int row[RB]; bool ok[RB]; const float* mv[RB];
#pragma unroll
                for (int k = 0; k < RB; ++k) { const int r = r0 + k * NGW; const int t = r % TPB; ok[k] = (r < MROWS) && !(lastl && t >= SEQ); row[k] = ok[k] ? r : 0;
                    const int b = row[k] / TPB; mv[k] = modl + (size_t)(((row[k] % TPB) >= SEQ) ? 8 : b) * 6144; }
                f32x4 y[RB][4]; float s[RB];
#pragma unroll
                for (int k = 0; k < RB; ++k) { s[k] = 0.f;
#pragma unroll
                    for (int j = 0; j < 4; ++j) { y[k][j] = *(const f32x4*)(Y + (size_t)row[k] * DM + 4 * lane + 256 * j); s[k] += (y[k][j][0] + y[k][j][1]) + (y[k][j][2] + y[k][j][3]); } }
                float s2[RB];
#pragma unroll
                for (int k = 0; k < RB; ++k) { const float mean = wave_sum(s[k]) * (1.0f / 1024.0f); s2[k] = 0.f;
#pragma unroll
                    for (int j = 0; j < 4; ++j) { y[k][j] = y[k][j] - mean; s2[k] += (y[k][j][0] * y[k][j][0] + y[k][j][1] * y[k][j][1]) + (y[k][j][2] * y[k][j][2] + y[k][j][3] * y[k][j][3]); } }
                float rstd[RB];
#pragma unroll
                for (int k = 0; k < RB; ++k) rstd[k] = 1.0f / sqrtf(wave_sum(s2[k]) * (1.0f / 1024.0f) + LN_EPS);
#pragma unroll
                for (int j = 0; j < 4; ++j) { const int c = 4 * lane + 256 * j; const f32x4 gq = *(const f32x4*)(lg + c), bq = *(const f32x4*)(lb + c);
#pragma unroll
                    for (int k = 0; k < RB; ++k) {
                        const f32x4 xn = y[k][j] * rstd[k] * gq + bq;
                        const f32x4 hv = xn * (*(const f32x4*)(mv[k] + 4096 + c) + 1.0f) + *(const f32x4*)(mv[k] + 3072 + c);
                        y[k][j] = hv;
                        if (ok[k]) { *(f32x4*)(X + (size_t)row[k] * DM + c) = xn;
                            u32x2 w; w.x = cvt_pk_bf16(hv[0], hv[1]); w.y = cvt_pk_bf16(hv[2], hv[3]); *(u32x2*)(HB + (size_t)row[k] * DM + c) = w; } } }
                float gl[RB][4];
#pragma unroll
                for (int e = 0; e < 4; ++e) { float p[RB];
#pragma unroll
                    for (int k = 0; k < RB; ++k) p[k] = 0.f;
#pragma unroll
                    for (int j = 0; j < 4; ++j) { const f32x4 w = *(const f32x4*)(wr + (size_t)e * 1024 + 4 * lane + 256 * j);
#pragma unroll
                        for (int k = 0; k < RB; ++k) p[k] += (y[k][j][0] * w[0] + y[k][j][1] * w[1]) + (y[k][j][2] * w[2] + y[k][j][3] * w[3]); }
#pragma unroll
                    for (int k = 0; k < RB; ++k) gl[k][e] = wave_sum(p[k]) + bg[e]; }
                int gsel[RB]; float gprob[RB];
#pragma unroll
                for (int k = 0; k < RB; ++k) { gsel[k] = 0; float gmax = gl[k][0];
#pragma unroll
                    for (int e = 1; e < 4; ++e) if (gl[k][e] > gmax) { gmax = gl[k][e]; gsel[k] = e; }
                    float gden = 0.f;
#pragma unroll
                    for (int e = 0; e < 4; ++e) gden += expf(gl[k][e] - gmax);
                    gprob[k] = 1.0f / gden; }
                float el[RB][8];
#pragma unroll
                for (int k = 0; k < RB; ++k) { const float* wp0 = wr + (size_t)(4 + gsel[k] * 8) * 1024 + 4 * lane;
#pragma unroll
                    for (int e = 0; e < 8; ++e) { float p = 0.f;
#pragma unroll
                        for (int j = 0; j < 4; ++j) { const f32x4 w = *(const f32x4*)(wp0 + (size_t)e * 1024 + 256 * j); p += (y[k][j][0] * w[0] + y[k][j][1] * w[1]) + (y[k][j][2] * w[2] + y[k][j][3] * w[3]); }
                        el[k][e] = p; } }
#pragma unroll
                for (int k = 0; k < RB; ++k)
#pragma unroll
                    for (int e = 0; e < 8; ++e) el[k][e] = wave_sum(el[k][e]) + be[gsel[k] * 8 + e];
#pragma unroll
                for (int k = 0; k < RB; ++k) {
                    int i1 = 0; float v1 = el[k][0];
#pragma unroll
                    for (int e = 1; e < 8; ++e) if (el[k][e] > v1) { v1 = el[k][e]; i1 = e; }
                    int i2 = -1; float v2 = -3.0e38f;
#pragma unroll
                    for (int e = 0; e < 8; ++e) if (e != i1 && el[k][e] > v2) { v2 = el[k][e]; i2 = e; }
                    const float ex = expf(v2 - v1), w1 = gprob[k] / (1.0f + ex), w2 = gprob[k] * ex / (1.0f + ex);
                    if (lane == 0 && ok[k]) {
                        const int e1 = gsel[k] * 8 + i1, e2 = gsel[k] * 8 + i2;
                        const unsigned p1 = __hip_atomic_fetch_add(lc + e1, 1u, __ATOMIC_RELAXED, __HIP_MEMORY_SCOPE_WORKGROUP), p2 = __hip_atomic_fetch_add(lc + e2, 1u, __ATOMIC_RELAXED, __HIP_MEMORY_SCOPE_WORKGROUP);
                        LAS unsigned* ri = RI + (nslot + k) * 8;
                        ri[0] = (unsigned)row[k]; ri[1] = (unsigned)e1 | (p1 << 8); ri[2] = __float_as_uint(w1); ri[3] = (unsigned)e2 | (p2 << 8); ri[4] = __float_as_uint(w2);
                    }
                }
            }
            __syncthreads();
            if (tid < 32 && rep_ == 0) { const unsigned n = lc[tid]; gb[tid] = n ? atomicAdd(cnt + tid * 64, n) : 0u; }
            __syncthreads();
            if (tid < 128 && rep_ == 0) { const unsigned r = RI[tid * 8];
                if (r != 0xffffffffu) { const unsigned a1 = RI[tid * 8 + 1], a2 = RI[tid * 8 + 3]; const unsigned e1 = a1 & 255u, e2 = a2 & 255u, p1 = gb[e1] + (a1 >> 8), p2 = gb[e2] + (a2 >> 8);
                    LIST[(size_t)e1 * MROWS + p1] = (int)r; LIST[(size_t)e2 * MROWS + p2] = (int)r;
                    TOK[r] = (u32x4){e1 | (p1 << 8), RI[tid * 8 + 2], e2 | (p2 << 8), RI[tid * 8 + 4]}; }
            } }
            SEAM(P + 3);
        }
        if (IN(P + 4) || IN(P + 5) || IN(P + 6)) {
            PHASE_TID();
            __syncthreads();
            if (tid < 32) tab[tid] = (int)__hip_atomic_load((GAS unsigned*)CNTL + tid * 64, RLX_AGENT);
            __syncthreads();
            if (tid == 0) { int p = 0; for (int e = 0; e < 32; ++e) { tab[32 + e] = p; p += (tab[e] + 255) >> 8; } tab[64] = p; }
            __syncthreads();
        }
        if (EN(6) && IN(P + 4)) { REP(7) {
            MoeGuSched S{(const char*)WSP(bf16_t, WS_HB), (const char*)(WSP(bf16_t, WS_WGU) + (size_t)l * 32 * 1024 * 1024), WSP(int, WS_LIST), tab, G, vcu};
            EpiGU E{WSP(bf16_t, WS_HID)};
            pg8::gemm_phase(ring, 1024, S, E); }
            SEAM(P + 4);
        }
        if (EN(6) && IN(P + 5)) { REP(8) {
            MoeDownSched S{(const char*)WSP(bf16_t, WS_HID), (const char*)(WSP(bf16_t, WS_WD) + (size_t)l * 32 * 1024 * 512), tab, G, vcu};
            EpiDown E{WSP(bf16_t, WS_YS)};
            pg8::gemm_phase(ring, 512, S, E); }
            SEAM(P + 5);
        }
        if (EN(5) && IN(P + 6)) { REP(10) {
            const float* lg = opaque(args.in[6] + (size_t)(l * 2 + 1) * 1024); const float* lb = opaque(args.in[7] + (size_t)(l * 2 + 1) * 1024);
            float* X = WSP(float, WS_X); bf16_t* HB = WSP(bf16_t, WS_HB); const float* modl = MODL; u32x4* TOK = WSP(u32x4, WS_TOK); bf16_t* YS = WSP(bf16_t, WS_YS); float* MOD = WSP(float, WS_MOD); float* outp = opaque(args.out);
            float* Xo = rep_ ? WSP(float, WS_Y) : X; bf16_t* HBo = rep_ ? WSP(bf16_t, WS_STASH) : HB; if (rep_) outp = WSP(float, WS_Y);
            PHASE_TID();
            constexpr int RB = 3;
            for (int r0 = gw; r0 < MROWS; r0 += NGW * RB) {
                int row[RB]; bool ok[RB]; int bbk[RB];
#pragma unroll
                for (int k = 0; k < RB; ++k) { const int r = r0 + k * NGW; const int t = r % TPB; ok[k] = (r < MROWS) && !(lastl && t >= SEQ); row[k] = ok[k] ? r : 0;
                    bbk[k] = ((row[k] % TPB) >= SEQ) ? 8 : row[k] / TPB; }
                const bf16_t* ya[RB]; const bf16_t* yb[RB]; float w1[RB], w2[RB];
#pragma unroll
                for (int k = 0; k < RB; ++k) { const u32x4 tk = TOK[row[k]];
                    const int e1 = tk.x & 255, p1 = tk.x >> 8, e2 = tk.z & 255, p2 = tk.z >> 8; w1[k] = __uint_as_float(tk.y); w2[k] = __uint_as_float(tk.w);
                    ya[k] = YS + ((size_t)tab[32 + e1] * 256 + p1) * DM; yb[k] = YS + ((size_t)tab[32 + e2] * 256 + p2) * DM; }
                f32x4 y[RB][4]; float s[RB];
#pragma unroll
                for (int k = 0; k < RB; ++k) { s[k] = 0.f; const float* g2 = modl + (size_t)bbk[k] * 6144 + 5120;
#pragma unroll
                    for (int j = 0; j < 4; ++j) { const int c = 4 * lane + 256 * j;
                        const u32x2 a = *(const u32x2*)(ya[k] + c), bq = *(const u32x2*)(yb[k] + c);
                        f32x4 f; f[0] = w1[k] * __uint_as_float(a.x << 16) + w2[k] * __uint_as_float(bq.x << 16); f[1] = w1[k] * __uint_as_float(a.x & 0xffff0000u) + w2[k] * __uint_as_float(bq.x & 0xffff0000u);
                        f[2] = w1[k] * __uint_as_float(a.y << 16) + w2[k] * __uint_as_float(bq.y << 16); f[3] = w1[k] * __uint_as_float(a.y & 0xffff0000u) + w2[k] * __uint_as_float(bq.y & 0xffff0000u);
                        y[k][j] = *(const f32x4*)(X + (size_t)row[k] * DM + c) * ALPHA + *(const f32x4*)(g2 + c) * f;
                        s[k] += (y[k][j][0] + y[k][j][1]) + (y[k][j][2] + y[k][j][3]); } }
                float s2[RB];
#pragma unroll
                for (int k = 0; k < RB; ++k) { const float mean = wave_sum(s[k]) * (1.0f / 1024.0f); s2[k] = 0.f;
#pragma unroll
                    for (int j = 0; j < 4; ++j) { y[k][j] = y[k][j] - mean; s2[k] += (y[k][j][0] * y[k][j][0] + y[k][j][1] * y[k][j][1]) + (y[k][j][2] * y[k][j][2] + y[k][j][3] * y[k][j][3]); } }
                float rstd[RB];
#pragma unroll
                for (int k = 0; k < RB; ++k) rstd[k] = 1.0f / sqrtf(wave_sum(s2[k]) * (1.0f / 1024.0f) + LN_EPS);
#pragma unroll
                for (int j = 0; j < 4; ++j) { const int c = 4 * lane + 256 * j; const f32x4 gq = *(const f32x4*)(lg + c), bq = *(const f32x4*)(lb + c);
#pragma unroll
                    for (int k = 0; k < RB; ++k) { if (!ok[k]) continue;
                        const f32x4 xn = y[k][j] * rstd[k] * gq + bq;
                        if (!lastl) { *(f32x4*)(Xo + (size_t)row[k] * DM + c) = xn;
                            const float* mvn = MOD + ((size_t)(l + 1) * 9 + bbk[k]) * 6144;
                            const f32x4 hv = xn * (*(const f32x4*)(mvn + 1024 + c) + 1.0f) + *(const f32x4*)(mvn + c);
                            u32x2 w; w.x = cvt_pk_bf16(hv[0], hv[1]); w.y = cvt_pk_bf16(hv[2], hv[3]); *(u32x2*)(HBo + (size_t)row[k] * DM + c) = w; }
                        else { const int b = row[k] / TPB, t = row[k] % TPB; *(f32x4*)(outp + ((size_t)b * SEQ + t) * DM + c) = xn; } } }
            } }
            SEAM(P + 6);
        }
    }
#undef IN
#undef SEAM
}

extern "C" void kernel_launch(void* const* d_in, const int* in_sizes, int n_in, void* d_out, int out_size, void* d_ws, size_t ws_size, hipStream_t stream) {
    static int grid = 0;
    if (grid == 0) {
        if (n_in != 29 || in_sizes[0] != NB * SEQ * DM || out_size != NB * SEQ * DM || ws_size < WS_END) { fprintf(stderr, "kernel_launch: unexpected shapes / workspace (n_in %d, ws %zu)\n", n_in, ws_size); grid = -1; return; }
        int dev = 0, cus = 0, per_cu = 0;
        if (hipGetDevice(&dev) != hipSuccess || hipDeviceGetAttribute(&cus, hipDeviceAttributeMultiprocessorCount, dev) != hipSuccess) { grid = -1; return; }
        if (hipFuncSetAttribute((const void*)fwd, hipFuncAttributeMaxDynamicSharedMemorySize, LDS_BYTES) != hipSuccess) { fprintf(stderr, "kernel_launch: hipFuncSetAttribute failed\n"); grid = -1; return; }
        if (hipOccupancyMaxActiveBlocksPerMultiprocessor(&per_cu, (const void*)fwd, 512, LDS_BYTES) != hipSuccess || per_cu < 1) fprintf(stderr, "kernel_launch: occupancy query says %d\n", per_cu);
        (void)hipGetLastError();
        grid = cus;
    }
    if (grid < 0) return;
    if (hipMemsetAsync((char*)d_ws + WS_CTL, 0, CTL_ZERO_BYTES, stream) != hipSuccess) return;
    Args a{};
    for (int i = 0; i < 29; ++i) a.in[i] = (const float*)d_in[i];
    a.out = (float*)d_out; a.ws = (unsigned char*)d_ws;
    if (MK_N_LAUNCHES == 1) { a.ph_lo = 0; a.ph_hi = NPHASE; hipLaunchKernelGGL(fwd, dim3(grid), dim3(512), LDS_BYTES, stream, a); }
    else for (int p = 0; p < NPHASE; ++p) { a.ph_lo = p; a.ph_hi = p + 1; hipLaunchKernelGGL(fwd, dim3(grid), dim3(512), LDS_BYTES, stream, a); }
    const hipError_t le = hipPeekAtLastError();
    if (le != hipSuccess) fprintf(stderr, "kernel_launch: launch failed: %s\n", hipGetErrorName(le));
}
```

```cpp
#include <hip/hip_runtime.h>
#include <hip/hip_bf16.h>
#include <cstdio>
#include <cstdint>

#ifndef MK_N_LAUNCHES
#define MK_N_LAUNCHES 1
#endif

#define LAS __attribute__((address_space(3)))
#define GAS __attribute__((address_space(1)))
typedef unsigned short bf16_t;
typedef short bf16x8 __attribute__((ext_vector_type(8)));
typedef short s16x4 __attribute__((ext_vector_type(4)));
typedef float f32x2 __attribute__((ext_vector_type(2)));
typedef float f32x4 __attribute__((ext_vector_type(4)));
typedef float f32x16 __attribute__((ext_vector_type(16)));
typedef unsigned u32x2 __attribute__((ext_vector_type(2)));
typedef unsigned u32x4 __attribute__((ext_vector_type(4)));

constexpr int DM = 1024, NB = 8, SEQ = 2048, CTXL = 256, TPB = SEQ + CTXL, MROWS = NB * TPB;
constexpr int DEPTH = 4, NEXP = 32, EFF = 512;
constexpr float ALPHA = 1.6817928305074292f;
constexpr float LN_EPS = 1e-5f, RMS_EPS = 1e-6f;
constexpr float LAM_INIT_C = 0.47071301834358416f;
constexpr int KSPLIT = 16;

constexpr size_t MiB = 1u << 20;
constexpr size_t WS_CTL = 0, CTL_ZERO_BYTES = 1 * MiB;
constexpr size_t WS_MOD = 1 * MiB;
constexpr size_t WS_ROPE = 2 * MiB;
constexpr size_t WS_WR = 2 * MiB + 64 * 1024;
constexpr size_t WS_PART = 3 * MiB;
constexpr size_t WS_TOK = 17 * MiB;
constexpr size_t WS_LIST = 18 * MiB;
constexpr size_t WS_WQKV = 21 * MiB;
constexpr size_t WS_WO = 36 * MiB;
constexpr size_t WS_WGU = 44 * MiB;
constexpr size_t WS_WD = 300 * MiB;
constexpr size_t WS_X = 428 * MiB;
constexpr size_t WS_Y = 500 * MiB;
constexpr size_t WS_HB = 572 * MiB;
constexpr size_t WS_QKV = 608 * MiB;
constexpr size_t WS_O = 716 * MiB;
constexpr size_t WS_HID = WS_QKV;
constexpr size_t WS_YS = 652 * MiB;
constexpr size_t WS_STASH = 752 * MiB;
constexpr size_t WS_END = 784 * MiB;
constexpr int MAXSLOT = 45056;
constexpr int CW_TMO = 0, CW_CODE = 1, CW_BAR = 4096, CW_CNT = 8192;

constexpr int MISC_OFF = 0;
constexpr int RING_OFF = 512, RING_BYTES = 131072;
constexpr int SS_OFF = RING_OFF + RING_BYTES;
constexpr int TAB_OFF = SS_OFF + 16384;
constexpr int RI_OFF = TAB_OFF + 1024;
constexpr int LDS_BYTES = RI_OFF + 4096 + 256;

#define RLX_AGENT __ATOMIC_RELAXED, __HIP_MEMORY_SCOPE_AGENT
template <class T> __device__ __forceinline__ T* opaque(T* p) { size_t z = 0; asm volatile("" : "+s"(z)); return (T*)((char*)p + z); }
__device__ __forceinline__ unsigned cvt_pk_bf16(float lo, float hi) { unsigned r; asm volatile("v_cvt_pk_bf16_f32 %0, %1, %2" : "=v"(r) : "v"(lo), "v"(hi)); return r; }
__device__ __forceinline__ float bf2f(unsigned short h) { return __uint_as_float(((unsigned)h) << 16); }
template <int M> __device__ __forceinline__ float lane_xor_add(float v) {
    if constexpr (M == 32) { auto rr = __builtin_amdgcn_permlane32_swap(__float_as_uint(v), __float_as_uint(v), false, false); return __uint_as_float(rr[0]) + __uint_as_float(rr[1]); }
    else return v + __int_as_float(__builtin_amdgcn_ds_swizzle(__float_as_int(v), (M << 10) | 0x1f));
}
__device__ __forceinline__ float wave_sum(float v) {
    v = lane_xor_add<1>(v); v = lane_xor_add<2>(v); v = lane_xor_add<4>(v); v = lane_xor_add<8>(v); v = lane_xor_add<16>(v); v = lane_xor_add<32>(v);
    return v;
}

#define XB_TMO      128
#define XB_XCNT(j)  (256  + 64 * (j))
#define XB_XSUB(j)  (1280 + 64 * (j))
#define XB_XGEN(j)  (2304 + 64 * (j))
#define XB_TOP      3328
#define XB_TOPGEN   3392
#define XCD_BAR_WORDS 3456
#define XB_SPIN_CAP (1u << 18)
__device__ __forceinline__ unsigned xb_ld(unsigned* p)              { return __hip_atomic_load(p, __ATOMIC_RELAXED, __HIP_MEMORY_SCOPE_AGENT); }
__device__ __forceinline__ unsigned xb_add(unsigned* p, unsigned v) { return __hip_atomic_fetch_add(p, v, __ATOMIC_RELAXED, __HIP_MEMORY_SCOPE_AGENT); }
__device__ __forceinline__ unsigned xb_xcc_id() { return (unsigned)__builtin_amdgcn_s_getreg((3 << 11) | 20) & 0xFu; }
#define XB_SPIN(cond, bar) do { unsigned _sp = 0; while (cond) { __builtin_amdgcn_s_sleep(1); \
    if ((++_sp & 255u) == 0u) { if (xb_ld(&(bar)[XB_TMO])) break; if (_sp > XB_SPIN_CAP) { atomicAdd(&(bar)[XB_TMO], 1u); break; } } } } while (0)
struct XcdBarrier { unsigned* bar; unsigned x; volatile LAS unsigned* st; };
__device__ __forceinline__ XcdBarrier xcd_barrier_post(unsigned* bar, volatile LAS unsigned* st) {
    XcdBarrier b; b.bar = bar; b.x = xb_xcc_id(); b.st = st;
    if (threadIdx.x == 0) (void)xb_add(&bar[XB_XCNT(b.x)], 1u);
    return b;
}
__device__ __forceinline__ void xcd_barrier_complete(unsigned* bar, unsigned x, unsigned& nloc, unsigned& nx) {
    const unsigned G = gridDim.x * gridDim.y * gridDim.z;
    unsigned sum, cnt, mine, sp = 0u;
    for (;;) {
        sum = 0u; cnt = 0u; mine = 0u;
#pragma unroll
        for (unsigned j = 0; j < 16; ++j) { const unsigned c = xb_ld(&bar[XB_XCNT(j)]); sum += c; cnt += (c > 0u) ? 1u : 0u; mine = (j == x) ? c : mine; }
        if (sum == G) break;
        __builtin_amdgcn_s_sleep(1);
        if ((++sp & 255u) == 0u) { if (xb_ld(&bar[XB_TMO])) break; if (sp > XB_SPIN_CAP) { atomicAdd(&bar[XB_TMO], 1u); break; } }
    }
    nloc = mine > 0u ? mine : 1u; nx = cnt > 0u ? cnt : 1u;
}
__device__ __forceinline__ void xcd_barrier(const XcdBarrier& b) {
    asm volatile("s_waitcnt vmcnt(0)" ::: "memory");
    __syncthreads();
    if (threadIdx.x == 0) {
        unsigned* bar = b.bar;
        __builtin_amdgcn_s_waitcnt(0);
        unsigned nloc = b.st[0], nx = b.st[1];
        if (nloc == 0u) { xcd_barrier_complete(bar, b.x, nloc, nx); b.st[0] = nloc; b.st[1] = nx; }
        const unsigned old = xb_add(&bar[XB_XSUB(b.x)], 1u);
        const unsigned gen = old / nloc;
        if (old + 1u == (gen + 1u) * nloc) {
            __builtin_amdgcn_fence(__ATOMIC_RELEASE, "agent");
            asm volatile("s_waitcnt vmcnt(0)" ::: "memory");
            const unsigned og = xb_add(&bar[XB_TOP], 1u);
            const unsigned tg = og / nx;
            if (og + 1u == (tg + 1u) * nx) xb_add(&bar[XB_TOPGEN], 1u);
            else XB_SPIN(xb_ld(&bar[XB_TOPGEN]) == tg, bar);
            __builtin_amdgcn_fence(__ATOMIC_ACQUIRE, "agent");
            xb_add(&bar[XB_XGEN(b.x)], 1u);
            asm volatile("s_waitcnt vmcnt(0)" ::: "memory");
        } else {
            XB_SPIN(xb_ld(&bar[XB_XGEN(b.x)]) == gen, bar);
            __builtin_amdgcn_fence(__ATOMIC_ACQUIRE, "agent");
            asm volatile("s_waitcnt vmcnt(0)" ::: "memory");
        }
    }
    __syncthreads();
}

namespace pg8 {
constexpr int BM = 256, BK = 64, HALF = 128, HTB = HALF * BK * 2, STAGE_BYTES = 8 * HTB;
__device__ __forceinline__ int lds_byte(int r, int c) { const int st = (r >> 4) * 2 + (c >> 5), rr = r & 15, cc = c & 31, ob = rr * 64 + cc * 2; return st * 1024 + (ob ^ (((ob >> 9) & 1) << 5)); }
__device__ __forceinline__ void stage_rc(int b, int& R, int& C) { const int st = b / 1024, sb = b % 1024, swz = sb ^ (((sb >> 9) & 1) << 5); R = (st >> 1) * 16 + swz / 64; C = (st & 1) * 32 + (swz % 64) / 2; }
struct Unit { int pm, pn, e, nrow; };

template <class Epi, class Sched>
__device__ __forceinline__ void gemm_phase(LAS unsigned char* lds, const int K, const Sched& S, const Epi& E) {
    int tid = threadIdx.x; asm volatile("" : "+v"(tid));
    const int wid = __builtin_amdgcn_readfirstlane(tid >> 6), lane = tid & 63, wr = wid >> 2, wc = wid & 3, fr = lane & 15, fq = lane >> 4;
    const int nt = K / BK;
    unsigned voffB[2];
#pragma unroll
    for (int i = 0; i < 2; ++i) { int R_, C_; stage_rc(tid * 16 + i * 8192, R_, C_); voffB[i] = (unsigned)(R_ * K + C_) * 2u; }
    const size_t kstep = (size_t)(BK * 2);
    const size_t hstepB = (size_t)HALF * K * 2;
    const unsigned ldsw = (unsigned)wid * 1024u;
    const int aoff = lds_byte(wr * 64 + fr, fq * 8), boff = lds_byte(wc * 32 + fr, fq * 8);
#define PG8_SA(b, h) (((b) * 2 + (h)) * HTB)
#define PG8_SB(b, h) ((4 + (b) * 2 + (h)) * HTB)
#define PG8_STAGE(bufoff, gbase, voff) do { _Pragma("unroll") for (int _i = 0; _i < 2; ++_i) \
        __builtin_amdgcn_global_load_lds((const unsigned*)((const char*)(gbase) + (voff)[_i]), (LAS unsigned*)(lds + (bufoff) + ldsw + _i * 8192), 16, 0, 0); } while (0)
#define PG8_LDA(dst, b, h) do { _Pragma("unroll") for (int m = 0; m < 4; ++m) _Pragma("unroll") for (int k = 0; k < 2; ++k) dst[m][k] = *(const LAS bf16x8*)(lds + PG8_SA(b, h) + aoff + m * 2048 + k * 1024); } while (0)
#define PG8_LDB(dst, b, h) do { _Pragma("unroll") for (int n = 0; n < 2; ++n) _Pragma("unroll") for (int k = 0; k < 2; ++k) dst[n][k] = *(const LAS bf16x8*)(lds + PG8_SB(b, h) + boff + n * 2048 + k * 1024); } while (0)
#define PG8_MMA(ai, bj, At, Bt) do { __builtin_amdgcn_s_setprio(1); _Pragma("unroll") for (int m = 0; m < 4; ++m) _Pragma("unroll") for (int n = 0; n < 2; ++n) _Pragma("unroll") for (int k = 0; k < 2; ++k) \
        acc[ai][bj][m][n] = __builtin_amdgcn_mfma_f32_16x16x32_bf16(Bt[n][k], At[m][k], acc[ai][bj][m][n], 0, 0, 0); __builtin_amdgcn_s_setprio(0); } while (0)
#define PG8_WAIT_V(n) asm volatile("s_waitcnt vmcnt(" #n ")" ::: "memory")
#define PG8_WAIT_L(n) asm volatile("s_waitcnt lgkmcnt(" #n ")" ::: "memory")
#define PG8_BAR __builtin_amdgcn_s_barrier()
#define PG8_SCHED __builtin_amdgcn_sched_barrier(0)
    Unit cur, nxt; int ui = 0;
    if (!S.next(0, cur)) return;
    f32x4 acc[2][2][4][2];
#pragma unroll
    for (int a = 0; a < 2; ++a)
#pragma unroll
        for (int b = 0; b < 2; ++b)
#pragma unroll
            for (int m = 0; m < 4; ++m)
#pragma unroll
                for (int n = 0; n < 2; ++n) acc[a][b][m][n] = (f32x4){0.f, 0.f, 0.f, 0.f};
    bf16x8 At[4][2], B0[2][2], B1[2][2];
    unsigned vA0[2], vA1[2], nA0[2], nA1[2];
    S.a_voff(cur, tid, K, vA0, vA1);
    const char* cA = S.a_ptr(cur); const char* cB = S.b_ptr(cur);
    PG8_STAGE(PG8_SB(0, 0), cB, voffB); PG8_STAGE(PG8_SB(0, 1), cB + hstepB, voffB); PG8_STAGE(PG8_SA(0, 0), cA, vA0); PG8_STAGE(PG8_SA(0, 1), cA, vA1);
    if (wr == 1) PG8_BAR;
    PG8_WAIT_V(2); PG8_BAR;
    PG8_STAGE(PG8_SB(1, 0), cB + kstep, voffB); PG8_STAGE(PG8_SA(1, 0), cA + kstep, vA0); PG8_STAGE(PG8_SB(1, 1), cB + hstepB + kstep, voffB);
    PG8_WAIT_V(6); PG8_BAR;
    for (;;) {
        const bool has_next = S.next(ui + 1, nxt);
        const char* nA = cA; const char* nB = cB;
#pragma unroll
        for (int i = 0; i < 2; ++i) { nA0[i] = vA0[i]; nA1[i] = vA1[i]; }
        if (has_next) { nA = S.a_ptr(nxt); nB = S.b_ptr(nxt); S.a_voff(nxt, tid, K, nA0, nA1); }
        for (int t = 0; t < nt; t += 2) {
            const bool last = (t == nt - 2);
            const char* a1 = cA + (size_t)(t + 1) * kstep;
            const char* a2 = last ? nA : cA + (size_t)(t + 2) * kstep; const char* b2 = last ? nB : cB + (size_t)(t + 2) * kstep;
            const char* a3 = a2 + kstep; const char* b3 = b2 + kstep;
            PG8_LDB(B0, 0, 0); PG8_LDB(B1, 0, 1); PG8_SCHED; PG8_LDA(At, 0, 0); PG8_STAGE(PG8_SA(1, 1), a1, vA1);
            if (last) {
#pragma unroll
                for (int i = 0; i < 2; ++i) { vA0[i] = nA0[i]; vA1[i] = nA1[i]; } }
            PG8_WAIT_V(8); PG8_WAIT_L(0); PG8_BAR; PG8_MMA(0, 0, At, B0); PG8_MMA(0, 1, At, B1); PG8_BAR; PG8_SCHED;
            PG8_LDA(At, 0, 1); PG8_STAGE(PG8_SB(0, 0), b2, voffB); PG8_STAGE(PG8_SB(0, 1), b2 + hstepB, voffB); PG8_STAGE(PG8_SA(0, 0), a2, vA0);
            PG8_WAIT_V(8); PG8_WAIT_L(0); PG8_BAR; PG8_MMA(1, 0, At, B0); PG8_MMA(1, 1, At, B1); PG8_BAR; PG8_SCHED;
            PG8_LDB(B0, 1, 0); PG8_LDB(B1, 1, 1); PG8_SCHED; PG8_LDA(At, 1, 0); PG8_STAGE(PG8_SA(0, 1), a2, vA1);
            PG8_WAIT_V(8); PG8_WAIT_L(0); PG8_BAR; PG8_MMA(0, 0, At, B0); PG8_MMA(0, 1, At, B1); PG8_BAR; PG8_SCHED;
            PG8_LDA(At, 1, 1); PG8_STAGE(PG8_SB(1, 0), b3, voffB); PG8_STAGE(PG8_SB(1, 1), b3 + hstepB, voffB); PG8_STAGE(PG8_SA(1, 0), a3, vA0);
            PG8_WAIT_V(8); PG8_WAIT_L(0); PG8_BAR; PG8_MMA(1, 0, At, B0); PG8_MMA(1, 1, At, B1); PG8_BAR; PG8_SCHED;
        }
        if (wr == 0) PG8_BAR;
        E(acc, cur, ui, wr, wc, fr, fq);
        if (!has_next) break;
#pragma unroll
        for (int a = 0; a < 2; ++a)
#pragma unroll
            for (int b = 0; b < 2; ++b)
#pragma unroll
                for (int m = 0; m < 4; ++m)
#pragma unroll
                    for (int n = 0; n < 2; ++n) acc[a][b][m][n] = (f32x4){0.f, 0.f, 0.f, 0.f};
        cur = nxt; cA = nA; cB = nB; ++ui;
        if (wr == 1) PG8_BAR;
    }
    PG8_WAIT_V(0);
    PG8_BAR;
#undef PG8_SA
#undef PG8_SB
#undef PG8_STAGE
#undef PG8_LDA
#undef PG8_LDB
#undef PG8_MMA
#undef PG8_WAIT_V
#undef PG8_WAIT_L
#undef PG8_BAR
#undef PG8_SCHED
}
}

struct DenseSched {
    const char* A; const char* Bt; int K, nM, nN, nwg, G, c, latonly;
    __device__ __forceinline__ void init(const void* A_, const void* Bt_, int K_, int nM_, int nN_, int G_, int c_, int latonly_) { A = (const char*)A_; Bt = (const char*)Bt_; K = K_; nM = nM_; nN = nN_; nwg = nM * nN; G = G_; c = c_; latonly = latonly_; }
    __device__ __forceinline__ bool next(int i, pg8::Unit& u) const {
        const long L = (long)i * G + c; if (L >= nwg) return false;
        int wgid = (int)L; { const int q = nwg / 8, r = nwg % 8, xcd = wgid % 8, off = wgid / 8; wgid = (xcd < r ? xcd * (q + 1) : r * (q + 1) + (xcd - r) * q) + off; }
        const int nig = 8 * nN, gid = wgid / nig, fm = gid * 8, gsz = (nM - fm) < 8 ? (nM - fm) : 8;
        int pm = fm + ((wgid % nig) % gsz); u.pn = (wgid % nig) / gsz;
        if (latonly) pm = (pm >> 3) * 9 + (pm & 7);
        u.pm = pm; u.e = 0; u.nrow = 0; return true;
    }
    __device__ __forceinline__ const char* a_ptr(const pg8::Unit& u) const { return A + (size_t)u.pm * 256 * K * 2; }
    __device__ __forceinline__ const char* b_ptr(const pg8::Unit& u) const { return Bt + (size_t)u.pn * 256 * K * 2; }
    __device__ __forceinline__ void a_voff(const pg8::Unit&, int tid, int K_, unsigned (&v0)[2], unsigned (&v1)[2]) const {
#pragma unroll
        for (int i = 0; i < 2; ++i) { int R, C; pg8::stage_rc(tid * 16 + i * 8192, R, C); v0[i] = (unsigned)(R * K_ + C) * 2u; v1[i] = (unsigned)((128 + R) * K_ + C) * 2u; }
    }
};
__device__ __forceinline__ int moe_find(const LAS int* tab, int mt) { int e = 0;
#pragma unroll 1
    for (int j = 1; j < 32; ++j) e = (tab[32 + j] <= mt) ? j : e;
    return e; }
struct MoeGuSched {
    const char* HB; const char* W; const int* list; const LAS int* tab; int G, c;
    __device__ __forceinline__ bool next(int i, pg8::Unit& u) const {
        const int L = i * G + c, T = tab[64]; if (L >= 4 * T) return false;
        const int mt = L >> 2; u.pm = mt; u.pn = L & 3; const int e = moe_find(tab, mt); u.e = e; u.nrow = mt - tab[32 + e]; return true;
    }
    __device__ __forceinline__ const char* a_ptr(const pg8::Unit&) const { return HB; }
    __device__ __forceinline__ const char* b_ptr(const pg8::Unit& u) const { return W + ((size_t)u.e * 1024 + (size_t)u.pn * 256) * 1024 * 2; }
    __device__ __forceinline__ void a_voff(const pg8::Unit& u, int tid, int K_, unsigned (&v0)[2], unsigned (&v1)[2]) const {
        const int n = tab[u.e]; const int* lp = list + (size_t)u.e * MROWS;
#pragma unroll
        for (int i = 0; i < 2; ++i) { int R, C; pg8::stage_rc(tid * 16 + i * 8192, R, C);
            int i0 = u.nrow * 256 + R, i1 = i0 + 128; i0 = i0 < n ? i0 : n - 1; i1 = i1 < n ? i1 : n - 1;
            const int t0 = lp[i0], t1 = lp[i1];
            v0[i] = (unsigned)(t0 * K_ + C) * 2u; v1[i] = (unsigned)(t1 * K_ + C) * 2u; }
    }
};
struct MoeDownSched {
    const char* HID; const char* W; const LAS int* tab; int G, c;
    __device__ __forceinline__ bool next(int i, pg8::Unit& u) const {
        const int L = i * G + c, T = tab[64]; if (L >= 4 * T) return false;
        const int mt = L >> 2; u.pm = mt; u.pn = L & 3; u.e = moe_find(tab, mt); u.nrow = 0; return true;
    }
    __device__ __forceinline__ const char* a_ptr(const pg8::Unit& u) const { return HID + (size_t)u.pm * 256 * EFF * 2; }
    __device__ __forceinline__ const char* b_ptr(const pg8::Unit& u) const { return W + ((size_t)u.e * 1024 + (size_t)u.pn * 256) * EFF * 2; }
    __device__ __forceinline__ void a_voff(const pg8::Unit&, int tid, int K_, unsigned (&v0)[2], unsigned (&v1)[2]) const {
#pragma unroll
        for (int i = 0; i < 2; ++i) { int R, C; pg8::stage_rc(tid * 16 + i * 8192, R, C); v0[i] = (unsigned)(R * K_ + C) * 2u; v1[i] = (unsigned)((128 + R) * K_ + C) * 2u; }
    }
};

template <int KIND> struct EpiQKV {
    bf16_t* out; int ldo; const float* rope; const float* qg; const float* kg; LAS float* ss;
    __device__ __forceinline__ void operator()(f32x4 (&acc)[2][2][4][2], const pg8::Unit& u, int ui, int wr, int wc, int fr, int fq) const {
        const int pmod = u.pm % 9; const bool is_ctx = (pmod == 8); const int tb = pmod * 256;
        constexpr int nrope = (KIND == 2) ? 8 : 5;
        const bool isqk = u.pn < nrope, do_rope = isqk && !is_ctx;
        constexpr int NF = (KIND == 0) ? 32 : 16;
        const int axis = (KIND == 0) ? (wc >> 1) : (wc & 1), f0 = (KIND == 0) ? ((wc & 1) * 16 + 4 * fq) : 4 * fq;
        LAS float* S = ss + (ui & 1) * 2048;
        f32x4 g0 = (f32x4){1.f, 1.f, 1.f, 1.f}, g1 = g0;
        if constexpr (KIND == 0) {
#pragma unroll
            for (int ai = 0; ai < 2; ++ai)
#pragma unroll
                for (int m = 0; m < 4; ++m)
#pragma unroll
                    for (int bj = 0; bj < 2; ++bj) {
                        const f32x4 a = acc[ai][bj][m][0], b = acc[ai][bj][m][1];
                        float s = (a[0] * a[0] + a[1] * a[1]) + (a[2] * a[2] + a[3] * a[3]) + (b[0] * b[0] + b[1] * b[1]) + (b[2] * b[2] + b[3] * b[3]);
                        s = lane_xor_add<16>(s); s = lane_xor_add<32>(s);
                        if (fq == 0) S[(ai * 128 + wr * 64 + m * 16 + fr) * 8 + bj * 4 + wc] = s;
                    }
            asm volatile("s_waitcnt lgkmcnt(0)" ::: "memory"); __builtin_amdgcn_s_barrier(); asm volatile("" ::: "memory");
            if (isqk) { const float* gain = (u.pn < 4) ? qg : kg; g0 = *(const f32x4*)(gain + axis * 64 + f0); g1 = *(const f32x4*)(gain + axis * 64 + 32 + f0); }
        }
#pragma unroll
        for (int ai = 0; ai < 2; ++ai)
#pragma unroll
            for (int m = 0; m < 4; ++m) {
                const int rt = ai * 128 + wr * 64 + m * 16 + fr, t = tb + rt, pos = axis ? (t & 63) : (t >> 6);
                f32x4 cs = (f32x4){1.f, 1.f, 1.f, 1.f}, sn = (f32x4){0.f, 0.f, 0.f, 0.f};
                if (do_rope) { cs = *(const f32x4*)(rope + pos * NF + f0); sn = *(const f32x4*)(rope + 64 * NF + pos * NF + f0); }
                bf16_t* rowp = out + (size_t)(u.pm * 256 + rt) * ldo + u.pn * 256 + wc * 32 + 4 * fq;
#pragma unroll
                for (int bj = 0; bj < 2; ++bj) {
                    f32x4 x1 = acc[ai][bj][m][0], x2 = acc[ai][bj][m][1];
                    if constexpr (KIND == 0) { if (isqk) {
                        const f32x4 pp = *(const LAS f32x4*)(S + rt * 8 + bj * 4);
                        const float r = 1.0f / sqrtf(((pp[0] + pp[1]) + (pp[2] + pp[3])) * (1.0f / 128.0f) + RMS_EPS);
                        x1 = x1 * r * g0; x2 = x2 * r * g1; } }
                    const f32x4 o1 = x1 * cs - x2 * sn, o2 = x1 * sn + x2 * cs;
                    u32x2 w; w.x = cvt_pk_bf16(o1[0], o1[1]); w.y = cvt_pk_bf16(o1[2], o1[3]); *(u32x2*)(rowp + bj * 128) = w;
                    w.x = cvt_pk_bf16(o2[0], o2[1]); w.y = cvt_pk_bf16(o2[2], o2[3]); *(u32x2*)(rowp + bj * 128 + 16) = w;
                }
                asm volatile("" ::: "memory");
            }
    }
};
struct EpiWo {
    const float* X; float* Y; const float* mod;
    __device__ __forceinline__ void operator()(f32x4 (&acc)[2][2][4][2], const pg8::Unit& u, int, int wr, int wc, int fr, int fq) const {
        const int bb = (u.pm % 9 == 8) ? 8 : u.pm / 9; const float* g1 = mod + bb * 6144 + 2048;
        const int col0 = u.pn * 256 + wc * 32 + 4 * fq;
        f32x4 gv[2][2];
#pragma unroll
        for (int bj = 0; bj < 2; ++bj)
#pragma unroll
            for (int n = 0; n < 2; ++n) gv[bj][n] = *(const f32x4*)(g1 + col0 + bj * 128 + n * 16);
#pragma unroll
        for (int ai = 0; ai < 2; ++ai)
#pragma unroll
            for (int m = 0; m < 4; ++m) { const size_t off = (size_t)(u.pm * 256 + ai * 128 + wr * 64 + m * 16 + fr) * DM + col0;
#pragma unroll
                for (int bj = 0; bj < 2; ++bj)
#pragma unroll
                    for (int n = 0; n < 2; ++n) { const f32x4 xv = *(const f32x4*)(X + off + bj * 128 + n * 16); *(f32x4*)(Y + off + bj * 128 + n * 16) = xv * ALPHA + gv[bj][n] * acc[ai][bj][m][n]; }
                if (m & 1) asm volatile("" ::: "memory"); }
    }
};
struct EpiGU {
    bf16_t* HID;
    __device__ __forceinline__ void operator()(f32x4 (&acc)[2][2][4][2], const pg8::Unit& u, int, int wr, int wc, int fr, int fq) const {
#pragma unroll
        for (int ai = 0; ai < 2; ++ai)
#pragma unroll
            for (int m = 0; m < 4; ++m) { bf16_t* rowp = HID + (size_t)(u.pm * 256 + ai * 128 + wr * 64 + m * 16 + fr) * EFF + u.pn * 128 + wc * 32 + 4 * fq;
#pragma unroll
                for (int n = 0; n < 2; ++n) { const f32x4 a = acc[ai][0][m][n], b = acc[ai][1][m][n]; f32x4 h;
#pragma unroll
                    for (int j = 0; j < 4; ++j) h[j] = a[j] * __builtin_amdgcn_rcpf(1.0f + __expf(-a[j])) * b[j];
                    u32x2 w; w.x = cvt_pk_bf16(h[0], h[1]); w.y = cvt_pk_bf16(h[2], h[3]); *(u32x2*)(rowp + n * 16) = w; } }
    }
};
struct EpiDown {
    bf16_t* YS;
    __device__ __forceinline__ void operator()(f32x4 (&acc)[2][2][4][2], const pg8::Unit& u, int, int wr, int wc, int fr, int fq) const {
#pragma unroll
        for (int ai = 0; ai < 2; ++ai)
#pragma unroll
            for (int m = 0; m < 4; ++m) { bf16_t* rowp = YS + (size_t)(u.pm * 256 + ai * 128 + wr * 64 + m * 16 + fr) * DM + u.pn * 256 + wc * 32 + 4 * fq;
#pragma unroll
                for (int bj = 0; bj < 2; ++bj)
#pragma unroll
                    for (int n = 0; n < 2; ++n) { const f32x4 v = acc[ai][bj][m][n]; u32x2 w; w.x = cvt_pk_bf16(v[0], v[1]); w.y = cvt_pk_bf16(v[2], v[3]); *(u32x2*)(rowp + bj * 128 + n * 16) = w; } }
    }
};

namespace att {
#define SBAR() __builtin_amdgcn_sched_barrier(0)
__device__ __forceinline__ int crow(int r, int hi) { return (r & 3) + 8 * (r >> 2) + 4 * hi; }
template <int DQK> __device__ __forceinline__ int kswz(int row, int colB) { return row * (DQK * 2) + (colB ^ ((row & 7) << 4)); }
template <int NCB> __device__ __forceinline__ int v_st(int k, int c) { const int kk = (k & ~0xC) | ((k & 4) << 1) | ((k & 8) >> 1); return ((kk >> 3) * NCB + (c >> 5)) * 512 + ((kk & 7) * 32 + (c & 31)) * 2; }
__device__ __forceinline__ int v_rd_base(int lane) { return ((lane & 3) << 3) | (((lane >> 2) & 3) << 6) | (((lane >> 4) & 1) << 5) | (((lane >> 5) & 1) << 8); }
template <int NCB> constexpr int v_rd_off(int d0, int ks, int half) { return d0 * 512 + ks * (2 * NCB * 512) + half * (NCB * 512); }
template <int OFF> __device__ __forceinline__ s16x4 tr_read(int vb) { s16x4 r; asm volatile("ds_read_b64_tr_b16 %0, %1 offset:%2" : "=&v"(r) : "v"(vb), "i"(OFF) : "memory"); return r; }

template <int DQK> __device__ __forceinline__ void partialSM(f32x16& p0, f32x16& p1, float& m_reg, float& mn, float& alpha) {
    constexpr float SCALE = (DQK == 128) ? 0.088388347648318440f : 0.125f, C = SCALE * 1.4426950408889634f, THRS = 8.f / SCALE;
    float pmax = p0[0];
#pragma unroll
    for (int r = 1; r < 16; ++r) pmax = fmaxf(pmax, p0[r]);
#pragma unroll
    for (int r = 0; r < 16; ++r) pmax = fmaxf(pmax, p1[r]);
    { auto rr = __builtin_amdgcn_permlane32_swap(__float_as_uint(pmax), __float_as_uint(pmax), false, false); pmax = fmaxf(__uint_as_float(rr[0]), __uint_as_float(rr[1])); }
    if (__builtin_expect(__all(pmax - m_reg <= THRS), 1)) { mn = m_reg; alpha = 1.f; }
    else { mn = fmaxf(m_reg, pmax); alpha = __builtin_amdgcn_exp2f((m_reg - mn) * C); m_reg = mn; }
    const float mnC = -mn * C;
#pragma unroll
    for (int r = 0; r < 16; ++r) p0[r] = fmaf(p0[r], C, mnC);
#pragma unroll
    for (int r = 0; r < 16; ++r) p1[r] = fmaf(p1[r], C, mnC);
#pragma unroll
    for (int r = 0; r < 16; ++r) p0[r] = __builtin_amdgcn_exp2f(p0[r]);
}
__device__ __forceinline__ void finishSM(f32x16& p0, f32x16& p1, float alpha, float& l_reg, bf16x8& pa0, bf16x8& pa1, bf16x8& pa2, bf16x8& pa3) {
#pragma unroll
    for (int r = 0; r < 16; ++r) p1[r] = __builtin_amdgcn_exp2f(p1[r]);
    float ps = 0;
#pragma unroll
    for (int r = 0; r < 16; ++r) ps += p0[r];
#pragma unroll
    for (int r = 0; r < 16; ++r) ps += p1[r];
    { auto rr = __builtin_amdgcn_permlane32_swap(__float_as_uint(ps), __float_as_uint(ps), false, false); ps = __uint_as_float(rr[0]) + __uint_as_float(rr[1]); }
    l_reg = l_reg * alpha + ps;
#define PK4(P, BASE, OUT) do { unsigned a0 = cvt_pk_bf16(P[BASE + 0], P[BASE + 1]), a1 = cvt_pk_bf16(P[BASE + 2], P[BASE + 3]);   \
    unsigned b0 = cvt_pk_bf16(P[BASE + 4], P[BASE + 5]), b1 = cvt_pk_bf16(P[BASE + 6], P[BASE + 7]);                              \
    auto r0 = __builtin_amdgcn_permlane32_swap(a0, b0, false, false); auto r1 = __builtin_amdgcn_permlane32_swap(a1, b1, false, false); \
    u32x4 w = {r0[0], r1[0], r0[1], r1[1]}; OUT = __builtin_bit_cast(bf16x8, w); } while (0)
    PK4(p0, 0, pa0); PK4(p0, 8, pa1); PK4(p1, 0, pa2); PK4(p1, 8, pa3);
#undef PK4
}
template <int DQK> __device__ __forceinline__ void qkt(f32x16& p0, f32x16& p1, const LAS char* Ks, const bf16x8* qr, int r32, int hi) {
    p0 = f32x16{}; p1 = f32x16{};
#pragma unroll
    for (int d0 = 0; d0 < DQK / 16; ++d0) { const int cb = (d0 * 16 + hi * 8) * 2;
        const bf16x8 b0 = *(const LAS bf16x8*)(Ks + kswz<DQK>(r32, cb));
        const bf16x8 b1 = *(const LAS bf16x8*)(Ks + kswz<DQK>(32 + r32, cb));
        p0 = __builtin_amdgcn_mfma_f32_32x32x16_bf16(b0, qr[d0], p0, 0, 0, 0);
        p1 = __builtin_amdgcn_mfma_f32_32x32x16_bf16(b1, qr[d0], p1, 0, 0, 0); }
}
template <int NCB, int D0> __device__ __forceinline__ void pv_one(f32x16& od, int vb, bf16x8 pa0, bf16x8 pa1, bf16x8 pa2, bf16x8 pa3) {
    const s16x4 l0 = tr_read<v_rd_off<NCB>(D0, 0, 0)>(vb), h0 = tr_read<v_rd_off<NCB>(D0, 0, 1)>(vb), l1 = tr_read<v_rd_off<NCB>(D0, 1, 0)>(vb), h1 = tr_read<v_rd_off<NCB>(D0, 1, 1)>(vb);
    const s16x4 l2 = tr_read<v_rd_off<NCB>(D0, 2, 0)>(vb), h2 = tr_read<v_rd_off<NCB>(D0, 2, 1)>(vb), l3 = tr_read<v_rd_off<NCB>(D0, 3, 0)>(vb), h3 = tr_read<v_rd_off<NCB>(D0, 3, 1)>(vb);
    asm volatile("s_waitcnt lgkmcnt(0)" ::: "memory"); SBAR();
#define PK(L, H) (bf16x8){L[0], L[1], L[2], L[3], H[0], H[1], H[2], H[3]}
    od = __builtin_amdgcn_mfma_f32_32x32x16_bf16(pa0, PK(l0, h0), od, 0, 0, 0);
    od = __builtin_amdgcn_mfma_f32_32x32x16_bf16(pa1, PK(l1, h1), od, 0, 0, 0);
    od = __builtin_amdgcn_mfma_f32_32x32x16_bf16(pa2, PK(l2, h2), od, 0, 0, 0);
    od = __builtin_amdgcn_mfma_f32_32x32x16_bf16(pa3, PK(l3, h3), od, 0, 0, 0);
#undef PK
}
template <int DV> __device__ __forceinline__ void pv_all(f32x16 (&o)[DV / 32], int vb, bf16x8 pa0, bf16x8 pa1, bf16x8 pa2, bf16x8 pa3) {
    constexpr int NCB = DV / 32;
    pv_one<NCB, 0>(o[0], vb, pa0, pa1, pa2, pa3); pv_one<NCB, 1>(o[1], vb, pa0, pa1, pa2, pa3);
    if constexpr (DV == 128) { pv_one<NCB, 2>(o[2], vb, pa0, pa1, pa2, pa3); pv_one<NCB, 3>(o[3], vb, pa0, pa1, pa2, pa3); }
}

template <int DQK, int DV, bool WIN>
__device__ __forceinline__ void attn_core(const bf16_t* __restrict__ Qb, const int ldq, const bf16_t* __restrict__ Kh, const bf16_t* __restrict__ Vh, const int ldk,
                                          const int NT, const int nfirst, const int base1, const int base2, const int qpos0,
                                          LAS char* lds, f32x16 (&o)[DV / 32], float& m_out, float& l_out) {
    constexpr int SHM_V = 64 * DV * 2, SHM_K = 64 * DQK * 2, KP = DQK / 64, VP = DV / 64, NCB = DV / 32, ND = DQK / 16;
    int tid = threadIdx.x; asm volatile("" : "+v"(tid));
    const int wid = tid >> 6, lane = tid & 63, r32 = lane & 31, hi = lane >> 5;
    LAS char* V_lds = lds; LAS char* K_lds = lds + 2 * SHM_V;
    LAS float* ws = (LAS float*)(lds + 2 * SHM_V + 2 * SHM_K) + wid * 64; LAS float* al_l = ws + 32;
    float m_reg = -1e30f, l_reg = 0.f;
#pragma unroll
    for (int d = 0; d < DV / 32; ++d) o[d] = f32x16{};
    bf16x8 qr[ND];
    const bf16_t* Qw = Qb + (size_t)(wid * 32 + r32) * ldq + hi * 8;
#pragma unroll
    for (int d0 = 0; d0 < ND; ++d0) qr[d0] = *(const bf16x8*)(Qw + d0 * 16);
    const int ksr = (KP == 2) ? (tid >> 4) : (tid >> 3), ksc = (KP == 2) ? (tid & 15) * 8 : (tid & 7) * 8;
    const int vsr = (VP == 2) ? (tid >> 4) : (tid >> 3), vsc = (VP == 2) ? (tid & 15) * 8 : (tid & 7) * 8;
    const int kst0 = kswz<DQK>(ksr, ksc * 2), kst1 = kswz<DQK>(32 + ksr, ksc * 2), vst0 = v_st<NCB>(vsr, vsc), vst1 = v_st<NCB>(32 + vsr, vsc);
    const int vb0 = (int)(unsigned)(uintptr_t)V_lds + v_rd_base(lane);
    struct { bf16x8 vs0, vs1, ks0, ks1; } sr_[2];
#define KB(j) (((j) < nfirst) ? base1 + 64 * (j) : base2 + 64 * ((j) - nfirst))
#define SLOAD(i, j) do { const int kb_ = KB(j); sr_[i].ks0 = *(const bf16x8*)(&Kh[(size_t)(kb_ + ksr) * ldk + ksc]); if (KP == 2) sr_[i].ks1 = *(const bf16x8*)(&Kh[(size_t)(kb_ + 32 + ksr) * ldk + ksc]); \
    sr_[i].vs0 = *(const bf16x8*)(&Vh[(size_t)(kb_ + vsr) * ldk + vsc]); if (VP == 2) sr_[i].vs1 = *(const bf16x8*)(&Vh[(size_t)(kb_ + 32 + vsr) * ldk + vsc]); } while (0)
#define SWRITE(b, i) do { *(LAS bf16x8*)(V_lds + (b) * SHM_V + vst0) = sr_[i].vs0; if (VP == 2) *(LAS bf16x8*)(V_lds + (b) * SHM_V + vst1) = sr_[i].vs1; \
    *(LAS bf16x8*)(K_lds + (b) * SHM_K + kst0) = sr_[i].ks0; if (KP == 2) *(LAS bf16x8*)(K_lds + (b) * SHM_K + kst1) = sr_[i].ks1; } while (0)
#define RESC(a) do { if (__any((a) < 1.f)) { if (hi == 0) al_l[r32] = (a); asm volatile("s_waitcnt lgkmcnt(0)" ::: "memory"); \
    _Pragma("unroll") for (int d = 0; d < DV / 32; ++d) _Pragma("unroll") for (int r = 0; r < 16; ++r) o[d][r] *= al_l[crow(r, hi)]; } } while (0)
#define MASK(P0, P1, j) do { if (WIN && (j) >= nfirst) { const int dq_ = base2 + 64 * ((j) - nfirst) - (qpos0 + wid * 32 + r32); \
    _Pragma("unroll") for (int r = 0; r < 16; ++r) { const int dd_ = dq_ + crow(r, hi); if ((unsigned)(dd_ + 128) > 256u) P0[r] = -1e30f; if ((unsigned)(dd_ + 160) > 256u) P1[r] = -1e30f; } } } while (0)
    f32x16 pA0, pA1, pB0, pB1; float mnA, mnB, alA, alB; bf16x8 pa0, pa1, pa2, pa3;
    SLOAD(0, 0); asm volatile("s_waitcnt vmcnt(0)" ::: "memory"); SWRITE(0, 0); __syncthreads();
    qkt<DQK>(pA0, pA1, K_lds, qr, r32, hi); MASK(pA0, pA1, 0); partialSM<DQK>(pA0, pA1, m_reg, mnA, alA);
    SLOAD(1, 1); if (2 < NT) SLOAD(0, 2);
    SWRITE(1, 1); __syncthreads();
    for (int j = 1; j + 1 < NT; j += 2) {
        SBAR(); qkt<DQK>(pB0, pB1, K_lds + SHM_K, qr, r32, hi); MASK(pB0, pB1, j);
        finishSM(pA0, pA1, alA, l_reg, pa0, pa1, pa2, pa3); SBAR();
        SLOAD(1, j + 2); SBAR();
        pv_all<DV>(o, vb0, pa0, pa1, pa2, pa3); partialSM<DQK>(pB0, pB1, m_reg, mnB, alB);
        __syncthreads(); SWRITE(0, 0);
        RESC(alB); __syncthreads();
        SBAR(); qkt<DQK>(pA0, pA1, K_lds, qr, r32, hi); MASK(pA0, pA1, j + 1);
        finishSM(pB0, pB1, alB, l_reg, pa0, pa1, pa2, pa3); SBAR();
        if (j + 3 < NT) SLOAD(0, j + 3); SBAR();
        pv_all<DV>(o, vb0 + SHM_V, pa0, pa1, pa2, pa3); partialSM<DQK>(pA0, pA1, m_reg, mnA, alA);
        __syncthreads(); SWRITE(1, 1);
        RESC(alA); __syncthreads();
    }
    SBAR(); qkt<DQK>(pB0, pB1, K_lds + SHM_K, qr, r32, hi); MASK(pB0, pB1, NT - 1);
    finishSM(pA0, pA1, alA, l_reg, pa0, pa1, pa2, pa3); SBAR();
    pv_all<DV>(o, vb0, pa0, pa1, pa2, pa3); partialSM<DQK>(pB0, pB1, m_reg, mnB, alB);
    __syncthreads(); RESC(alB);
    finishSM(pB0, pB1, alB, l_reg, pa0, pa1, pa2, pa3); SBAR();
    pv_all<DV>(o, vb0 + SHM_V, pa0, pa1, pa2, pa3);
    m_out = m_reg; l_out = l_reg;
#undef KB
#undef SLOAD
#undef SWRITE
#undef RESC
#undef MASK
}
__device__ __forceinline__ void row_bcast(LAS float* ws, float v, int r32, int hi, float (&out)[16]) {
    if (hi == 0) ws[r32] = v; asm volatile("s_waitcnt lgkmcnt(0)" ::: "memory");
#pragma unroll
    for (int r = 0; r < 16; ++r) out[r] = ws[crow(r, hi)];
    asm volatile("s_waitcnt lgkmcnt(0)" ::: "memory");
}
#undef SBAR
}

constexpr int NPHASE = 3 + 7 * DEPTH;
struct Args { const float* in[29]; float* out; unsigned char* ws; int ph_lo, ph_hi; };

__device__ __forceinline__ void sincos_small(double x, double& s, double& c) {
    const double k = __builtin_rint(x * 0.6366197723675814);
    const double r = (x - k * 1.5707963267341256) - k * 6.077100506506192e-11;
    const double r2 = r * r;
    double sp = 1.0 / 6402373705728000.0, cp = 1.0 / 355687428096000.0;
    double cs = -sp; cs = cs * r2 + 1.0 / 20922789888000.0; cs = cs * r2 - 1.0 / 87178291200.0; cs = cs * r2 + 1.0 / 479001600.0; cs = cs * r2 - 1.0 / 3628800.0;
    cs = cs * r2 + 1.0 / 40320.0; cs = cs * r2 - 1.0 / 720.0; cs = cs * r2 + 1.0 / 24.0; cs = cs * r2 - 0.5; cs = cs * r2 + 1.0;
    double sn = cp; sn = sn * r2 - 1.0 / 1307674368000.0; sn = sn * r2 + 1.0 / 6227020800.0; sn = sn * r2 - 1.0 / 39916800.0; sn = sn * r2 + 1.0 / 362880.0;
    sn = sn * r2 - 1.0 / 5040.0; sn = sn * r2 + 1.0 / 120.0; sn = sn * r2 - 1.0 / 6.0; sn = sn * r2 + 1.0; sn = sn * r;
    const int q = ((int)k) & 3;
    s = (q == 0) ? sn : (q == 1) ? cs : (q == 2) ? -sn : -cs;
    c = (q == 0) ? cs : (q == 1) ? -sn : (q == 2) ? -cs : sn;
}

__device__ __forceinline__ void tile_load(f32x4 (&v)[16], const float* __restrict__ src, int N, int k0, int n0, int lane) {
    const int rsub = lane >> 4, c4 = (lane & 15) * 4;
#pragma unroll
    for (int i = 0; i < 16; ++i) v[i] = __builtin_nontemporal_load((const f32x4*)(src + (size_t)(k0 + 4 * i + rsub) * N + n0 + c4));
}
__device__ __forceinline__ void tile_store(const f32x4 (&v)[16], int k0, bf16_t* __restrict__ dst, int ldk, int drow0, bool perm, LAS float* scr, int lane) {
    const int rsub = lane >> 4, c4 = (lane & 15) * 4;
#pragma unroll
    for (int i = 0; i < 16; ++i) { LAS float* p = scr + (4 * i + rsub) * 65 + c4; p[0] = v[i][0]; p[1] = v[i][1]; p[2] = v[i][2]; p[3] = v[i][3]; }
    asm volatile("s_waitcnt lgkmcnt(0)" ::: "memory");
    const int c = lane & 7, nl = lane >> 3;
#pragma unroll
    for (int j = 0; j < 8; ++j) { const int n = nl + 8 * j; const LAS float* s = scr + (8 * c) * 65 + n;
        u32x4 o; o.x = cvt_pk_bf16(s[0], s[65]); o.y = cvt_pk_bf16(s[2 * 65], s[3 * 65]); o.z = cvt_pk_bf16(s[4 * 65], s[5 * 65]); o.w = cvt_pk_bf16(s[6 * 65], s[7 * 65]);
        const int nn = perm ? ((n & 15) | ((n & 16) << 1) | ((n & 32) >> 1)) : n;
        *(u32x4*)(dst + (size_t)(drow0 + nn) * ldk + k0 + 8 * c) = o; }
    asm volatile("s_waitcnt lgkmcnt(0)" ::: "memory");
}
__device__ __forceinline__ void transpose_tile(const float* __restrict__ src, int N, int k0, int n0, bf16_t* __restrict__ dst, int ldk, int drow0, bool perm, LAS float* scr, int lane) {
    f32x4 v[16]; tile_load(v, src, N, k0, n0, lane); tile_store(v, k0, dst, ldk, drow0, perm, scr, lane);
}

constexpr int CW_Q = 24576;
__device__ __forceinline__ void drain_moe_tiles(int l, int npull, unsigned* ctl, const float* wgate, const float* wup, const float* wdown, bf16_t* WGU, bf16_t* WD, LAS float* scr, int lane) {
    for (int n = 0; npull < 0 || n < npull; ++n) {
        unsigned id0 = 0; if (lane == 0) id0 = atomicAdd(ctl + CW_Q + l * 64, 4u);
        id0 = (unsigned)__builtin_amdgcn_readfirstlane((int)id0);
        if (id0 >= 12288u) break;
#define MOE_TILE(ID, SRC, NN, K0, N0, DST, LDK, DROW) do { const int id_ = (ID), which_ = id_ >> 12, r_ = id_ & 4095, lge_ = l * 32 + (r_ >> 7), rr_ = r_ & 127; \
        if (which_ < 2) { K0 = (rr_ >> 3) * 64; N0 = (rr_ & 7) * 64; NN = 512; SRC = (which_ ? wup : wgate) + (size_t)lge_ * 1024 * 512; DST = WGU; LDK = 1024; DROW = lge_ * 1024 + (N0 >> 7) * 256 + which_ * 128 + (N0 & 127); } \
        else { K0 = (rr_ >> 4) * 64; N0 = (rr_ & 15) * 64; NN = 1024; SRC = wdown + (size_t)lge_ * 512 * 1024; DST = WD; LDK = 512; DROW = lge_ * 1024 + N0; } } while (0)
        f32x4 va[16], vb[16]; const float* sa; const float* sb; bf16_t* da; bf16_t* db; int na, nb, ka, kb, n0a, n0b, la, lb, ra, rb;
        MOE_TILE((int)id0 + 0, sa, na, ka, n0a, da, la, ra); tile_load(va, sa, na, ka, n0a, lane);
        MOE_TILE((int)id0 + 1, sb, nb, kb, n0b, db, lb, rb); tile_load(vb, sb, nb, kb, n0b, lane);
        tile_store(va, ka, da, la, ra, false, scr, lane);
        MOE_TILE((int)id0 + 2, sa, na, ka, n0a, da, la, ra); tile_load(va, sa, na, ka, n0a, lane);
        tile_store(vb, kb, db, lb, rb, false, scr, lane);
        MOE_TILE((int)id0 + 3, sb, nb, kb, n0b, db, lb, rb); tile_load(vb, sb, nb, kb, n0b, lane);
        tile_store(va, ka, da, la, ra, false, scr, lane);
        tile_store(vb, kb, db, lb, rb, false, scr, lane);
#undef MOE_TILE
    }
}

__global__ void __launch_bounds__(512, 2) fwd(Args args) {
    extern __shared__ __attribute__((aligned(16))) unsigned char lds_raw[];
    LAS unsigned char* lds = (LAS unsigned char*)lds_raw;
    volatile LAS unsigned* MISC = (volatile LAS unsigned*)(lds + MISC_OFF);
    LAS unsigned char* ring = lds + RING_OFF;
    LAS int* tab = (LAS int*)(lds + TAB_OFF);
    const int wave = __builtin_amdgcn_readfirstlane((int)threadIdx.x >> 6);
#define PHASE_TID() int tid = threadIdx.x; asm volatile("" : "+v"(tid)); const int lane = tid & 63; (void)lane
    const int G = gridDim.x, bx = blockIdx.x;
    const int vcu = (G % 8 == 0) ? (bx % 8) * (G / 8) + bx / 8 : bx;
    const int gw = bx * 8 + wave, NGW = G * 8, NGT = G * 512;
    unsigned char* ws = args.ws;
    unsigned* ctl = (unsigned*)(ws + WS_CTL);
#define WSP(T, off) ((T*)(opaque(ws) + (off)))
#define DRAIN(L, NPULL) do { PHASE_TID(); drain_moe_tiles((L), (NPULL), (unsigned*)opaque(ws), args.in[26], args.in[27], args.in[28], WSP(bf16_t, WS_WGU), WSP(bf16_t, WS_WD), (LAS float*)ring + wave * (64 * 65), lane); } while (0)
    constexpr int PULLS_PER_UNIT = 1;
    if (threadIdx.x < 128) ((LAS unsigned*)(lds + MISC_OFF))[threadIdx.x] = 0u;
    __syncthreads();
    XcdBarrier bar; bar.bar = ctl + CW_BAR; bar.x = 0; bar.st = nullptr;
    if (MK_N_LAUNCHES == 1) bar = xcd_barrier_post(ctl + CW_BAR, MISC + 8);
    const int lo = args.ph_lo, hi = args.ph_hi;
#ifndef PHMASK
#define PHMASK 0x3ff
#endif
#define EN(bit) ((PHMASK >> (bit)) & 1)
#ifndef DUPMASK
#define DUPMASK 0
#endif
#define REP(k) _Pragma("unroll 1") for (int rep_ = 0; rep_ < (((DUPMASK >> (k)) & 1) ? 2 : 1); ++rep_)
#define IN(k) (lo <= (k) && (k) < hi)
#define SEAM(k) do { if (MK_N_LAUNCHES == 1) { if ((k) + 1 < hi) { xcd_barrier(bar); if ((DUPMASK >> 11) & 1) xcd_barrier(bar); } } } while (0)

    if (EN(0) && IN(0)) { REP(0) {
        PHASE_TID(); const int gt = bx * 512 + tid;
        const float* cvec = args.in[1]; const float* cctx = args.in[3]; const float* w_mod = args.in[4];
        float* PART = WSP(float, WS_PART); bf16_t* WQKV = WSP(bf16_t, WS_WQKV); bf16_t* WO = WSP(bf16_t, WS_WO);
        float* ROPE128 = WSP(float, WS_ROPE); float* ROPE64 = WSP(float, WS_ROPE + 16384); float* WR = WSP(float, WS_WR);
        LAS float* SL = (LAS float*)ring;
        for (int i = tid; i < 9 * 1024; i += 512) { const int bb = i >> 10, k = i & 1023; const float c = bb < 8 ? cvec[bb * 1024 + k] : cctx[k]; SL[i] = c / (1.0f + expf(-c)); }
        __syncthreads();
        for (int it = gw; it < 4 * 24 * KSPLIT; it += NGW) {
            const int ks = it % KSPLIT, cb = (it / KSPLIT) % 24, l = it / (KSPLIT * 24);
            f32x4 acc[9];
#pragma unroll
            for (int bb = 0; bb < 9; ++bb) acc[bb] = (f32x4){0.f, 0.f, 0.f, 0.f};
            const float* w = w_mod + ((size_t)l * 1024 + ks * 64) * 6144 + cb * 256 + 4 * lane;
#pragma unroll 8
            for (int kk = 0; kk < 64; ++kk) { const f32x4 wv = *(const f32x4*)(w + (size_t)kk * 6144);
#pragma unroll
                for (int bb = 0; bb < 9; ++bb) acc[bb] += SL[bb * 1024 + ks * 64 + kk] * wv; }
#pragma unroll
            for (int bb = 0; bb < 9; ++bb) *(f32x4*)(PART + (((size_t)ks * 4 + l) * 9 + bb) * 6144 + cb * 256 + 4 * lane) = acc[bb];
        }
        __syncthreads();
        LAS float* scr = (LAS float*)ring + wave * (64 * 65);
        constexpr int T_QKV = 1920, T_WO = 1024, T_ALL = T_QKV + T_WO;
        for (int id0 = gw; id0 < T_ALL; id0 += NGW) {
            int id = id0;
            if (id < T_QKV) {
                int l, r; if (id < 384) { l = 0; r = id; } else if (id < 768) { l = 1; r = id - 384; } else if (id < 1536) { l = 2; r = id - 768; } else { l = 3; r = id - 1536; }
                const int N = (l == 2) ? 3072 : 1536, nbN = N / 64, kb = r / nbN, nb = r % nbN;
                const float* src = (l == 0) ? args.in[8] : (l == 1) ? args.in[12] : (l == 2) ? args.in[15] : args.in[8] + (size_t)1024 * 1536;
                const int drow = (l == 0) ? 0 : (l == 1) ? 1536 : (l == 2) ? 3072 : 6144;
                const bool perm = (l == 0 || l == 3) && (nb * 64 < 1280);
                transpose_tile(src, N, kb * 64, nb * 64, WQKV, 1024, drow + nb * 64, perm, scr, lane);
            } else { id -= T_QKV;
                const int l = id >> 8, r = id & 255, kb = r >> 4, nb = r & 15;
                const float* src = (l == 0) ? args.in[11] : (l == 1) ? args.in[14] : (l == 2) ? args.in[21] : args.in[11] + (size_t)1024 * 1024;
                transpose_tile(src, 1024, kb * 64, nb * 64, WO + (size_t)l * 1024 * 1024, 1024, nb * 64, false, scr, lane);
            }
        }
        for (int i = gt; i < 64 * 32 + 64 * 16; i += NGT) {
            const bool big = i < 2048; const int ii = big ? i : i - 2048, NF = big ? 32 : 16, pos = ii / NF, f = ii % NF;
            const double base = big ? 0.7498942093324559 : 0.5623413251903491; double inv = 1.0;
            for (int q = 0; q < f; ++q) inv *= base;
            const float ang = (float)pos * (float)inv; double s, c; sincos_small((double)ang, s, c);
            float* Tt = big ? ROPE128 : ROPE64; Tt[ii] = (float)c; Tt[64 * NF + ii] = (float)s;
        }
        { const float* wg = args.in[22]; const float* we = args.in[24];
          for (int i = gt; i < 4 * 36 * 1024; i += NGT) { const int l = i / (36 * 1024), e = (i >> 10) % 36, c = i & 1023;
              WR[i] = (e < 4) ? wg[((size_t)l * 1024 + c) * 4 + e] : we[((size_t)l * 1024 + c) * 32 + (e - 4)]; } }
        __syncthreads(); }
        SEAM(0);
    }
    if (EN(1) && IN(1)) {
        PHASE_TID(); const int gt = bx * 512 + tid;
        const float* b_mod = args.in[5]; float* PART = WSP(float, WS_PART); float* MOD = WSP(float, WS_MOD);
        for (int i = gt; i < 4 * 9 * 6144; i += NGT) { const int l = i / 55296, bbj = i % 55296, j = bbj % 6144; float s = b_mod[l * 6144 + j];
#pragma unroll
            for (int ks = 0; ks < KSPLIT; ++ks) s += PART[((size_t)ks * 4 + l) * 55296 + bbj];
            MOD[i] = s; }
        SEAM(1);
    }
    if (EN(1) && IN(2)) { REP(1) {
        PHASE_TID();
        const float* xin = args.in[0]; const float* cin = args.in[2]; float* MOD = WSP(float, WS_MOD); float* X = WSP(float, WS_X); bf16_t* HB = WSP(bf16_t, WS_HB);
        for (int row = gw; row < MROWS; row += NGW) {
            const int b = row / TPB, t = row % TPB; const bool is_ctx = t >= SEQ; const int bb = is_ctx ? 8 : b;
            const float* src = is_ctx ? cin + ((size_t)b * CTXL + (t - SEQ)) * DM : xin + ((size_t)b * SEQ + t) * DM;
            const float* mv = MOD + (size_t)bb * 6144;
#pragma unroll
            for (int j = 0; j < 4; ++j) { const int c = 4 * lane + 256 * j; const f32x4 v = *(const f32x4*)(src + c);
                *(f32x4*)(X + (size_t)row * DM + c) = v;
                const f32x4 sh = *(const f32x4*)(mv + c), sc = *(const f32x4*)(mv + 1024 + c); const f32x4 h = v * (sc + 1.0f) + sh;
                u32x2 w; w.x = cvt_pk_bf16(h[0], h[1]); w.y = cvt_pk_bf16(h[2], h[3]); *(u32x2*)(HB + (size_t)row * DM + c) = w; }
        } }
        SEAM(2);
    }
#pragma unroll 1
    for (int l = 0; l < DEPTH; ++l) {
        const int kind = l % 3, P = 3 + 7 * l; const bool lastl = (l == DEPTH - 1);
#define MODL (WSP(float, WS_MOD) + (size_t)l * 9 * 6144)
        const int wq_row = (l == 0) ? 0 : (l == 1) ? 1536 : (l == 2) ? 3072 : 6144;
        const int NQ = (kind == 2) ? 3072 : 1536;
#define CNTL ((unsigned*)opaque(ws) + CW_CNT + l * 2048)
        if (EN(2) && IN(P + 0)) { REP(2) {
            DenseSched S; S.init(WSP(bf16_t, WS_HB), WSP(bf16_t, WS_WQKV) + (size_t)wq_row * 1024, 1024, 72, NQ / 256, G, bx, 0); bf16_t* qkv_o = WSP(bf16_t, WS_QKV);
            if (EN(7) && kind == 0) { EpiQKV<0> E{qkv_o, NQ, WSP(float, WS_ROPE), args.in[9] + (l / 3) * 128, args.in[10] + (l / 3) * 128, (LAS float*)(lds + SS_OFF)}; pg8::gemm_phase(ring, 1024, S, E); }
            else if (EN(8) && kind == 1) { EpiQKV<1> E{qkv_o, NQ, WSP(float, WS_ROPE + 16384), nullptr, nullptr, nullptr}; pg8::gemm_phase(ring, 1024, S, E); }
            else if (EN(9) && kind == 2) { EpiQKV<2> E{qkv_o, NQ, WSP(float, WS_ROPE + 16384), nullptr, nullptr, nullptr}; pg8::gemm_phase(ring, 1024, S, E); }
            { const int nwg = 72 * (NQ / 256), mx = (nwg + G - 1) / G, mine = (nwg > bx) ? (nwg - bx + G - 1) / G : 0; if (rep_ == 0 && mine < mx) DRAIN(l, (mx - mine) * PULLS_PER_UNIT); } }
            SEAM(P + 0);
        }
        if (EN(3) && IN(P + 1)) {
            LAS char* alds = (LAS char*)ring; bf16_t* QKV = WSP(bf16_t, WS_QKV); bf16_t* OB = WSP(bf16_t, WS_O); float* STASH = WSP(float, WS_STASH) + (size_t)bx * (64 * 512);
            PHASE_TID(); const int r32 = lane & 31, hh = lane >> 5;
            if (EN(7) && kind == 0) { REP(3) {
                LAS float* wsf = (LAS float*)(alds + 4 * 16384) + wave * 64;
                const int nlat = 512, nall = nlat + (lastl ? 0 : 64);
                for (int u = vcu; u < nall; u += G) {
                    int b, hq, q0, NT, base1;
                    if (u < nlat) { const int qb = u & 7, g = (u >> 3) & 3, kv = (u >> 5) & 1; b = u >> 6; hq = kv * 4 + g; q0 = qb * 256; NT = 36; base1 = 0; }
                    else { const int uc = u - nlat; hq = uc & 7; b = uc >> 3; q0 = 2048; NT = 4; base1 = 2048; }
                    const int kv = hq >> 2; const size_t rb = (size_t)b * TPB;
                    f32x16 o[4]; float m, lsum;
                    att::attn_core<128, 128, false>(opaque(QKV) + (rb + q0) * 1536 + hq * 128, 1536, opaque(QKV) + rb * 1536 + 1024 + kv * 128, opaque(QKV) + rb * 1536 + 1280 + kv * 128, 1536, NT, NT, base1, 0, 0, alds, o, m, lsum);
                    float rl[16]; att::row_bcast(wsf, 1.0f / lsum, r32, hh, rl);
                    bf16_t* Ow = opaque(OB) + (rb + q0 + wave * 32) * DM + hq * 128 + r32;
#pragma unroll
                    for (int r = 0; r < 16; ++r) { const int orow = att::crow(r, hh);
#pragma unroll
                        for (int d0 = 0; d0 < 4; ++d0) Ow[(size_t)orow * DM + d0 * 32] = (bf16_t)(cvt_pk_bf16(o[d0][r] * rl[r], 0.f) & 0xffffu); }
                }
            } } else if (EN(8) && kind == 1) { REP(4) {
                LAS float* wsf = (LAS float*)(alds + 4 * 8192) + wave * 64;
                const float* sink = opaque(args.in[13]);
                const int nlat = 1024, nall = nlat + (lastl ? 0 : 128);
                for (int u = vcu; u < nall; u += G) {
                    int b, hq, q0, NT, base2;
                    if (u < nlat) { const int qb = u & 7, g = (u >> 3) & 3, kv = (u >> 5) & 3; b = u >> 7; hq = kv * 4 + g; q0 = qb * 256;
                        const int klo = (q0 - 128) < 0 ? 0 : q0 - 128, khi = (q0 + 384) > SEQ ? SEQ : q0 + 384; base2 = klo; NT = 4 + (khi - klo) / 64; }
                    else { const int uc = u - nlat; hq = uc & 15; b = uc >> 4; q0 = 2048; NT = 4; base2 = 0; }
                    const int kv = hq >> 2; const size_t rb = (size_t)b * TPB;
                    f32x16 o[2]; float m, lsum;
                    att::attn_core<64, 64, true>(opaque(QKV) + (rb + q0) * 1536 + hq * 64, 1536, opaque(QKV) + rb * 1536 + 1024 + kv * 64, opaque(QKV) + rb * 1536 + 1280 + kv * 64, 1536, NT, 4, 2048, base2, q0, alds, o, m, lsum);
                    lsum += exp2f(sink[hq] * 1.4426950408889634f - m * (0.125f * 1.4426950408889634f));
                    float rl[16]; att::row_bcast(wsf, 1.0f / lsum, r32, hh, rl);
                    bf16_t* Ow = opaque(OB) + (rb + q0 + wave * 32) * DM + hq * 64 + r32;
#pragma unroll
                    for (int r = 0; r < 16; ++r) { const int orow = att::crow(r, hh);
#pragma unroll
                        for (int d0 = 0; d0 < 2; ++d0) Ow[(size_t)orow * DM + d0 * 32] = (bf16_t)(cvt_pk_bf16(o[d0][r] * rl[r], 0.f) & 0xffffu); }
                }
            } } else if (EN(9) && kind == 2) { REP(5) {
                LAS float* wsf = (LAS float*)(alds + 2 * 16384 + 2 * 8192) + wave * 64;
                const float lam = expf(wave_sum(opaque(args.in[16])[lane] * opaque(args.in[17])[lane])) - expf(wave_sum(opaque(args.in[18])[lane] * opaque(args.in[19])[lane])) + LAM_INIT_C;
                const float* sg = opaque(args.in[20]);
                const int nlat = 512, nall = nlat + (lastl ? 0 : 64);
                for (int u = vcu; u < nall; u += G) {
                    int b, h, q0, NT, base1;
                    if (u < nlat) { const int qb = u & 7; h = (u >> 3) & 7; b = u >> 6; q0 = qb * 256; NT = 36; base1 = 0; }
                    else { const int uc = u - nlat; h = uc & 7; b = uc >> 3; q0 = 2048; NT = 4; base1 = 2048; }
                    const size_t rb = (size_t)b * TPB;
#pragma unroll 1
                    for (int mp = 0; mp < 2; ++mp) {
                        f32x16 o[4]; float m, lsum; float rl[16];
                        att::attn_core<64, 128, false>(opaque(QKV) + (rb + q0) * 3072 + h * 128 + mp * 64, 3072, opaque(QKV) + rb * 3072 + 1024 + h * 128 + mp * 64, opaque(QKV) + rb * 3072 + 2048 + h * 128, 3072, NT, NT, base1, 0, 0, alds, o, m, lsum);
                        att::row_bcast(wsf, 1.0f / lsum, r32, hh, rl);
                        float* st = opaque(STASH) + tid;
                        if (mp == 0) {
#pragma unroll
                            for (int d0 = 0; d0 < 4; ++d0)
#pragma unroll
                                for (int r = 0; r < 16; ++r) st[(d0 * 16 + r) * 512] = o[d0][r] * rl[r];
                        } else {
                            const f32x4 gv = (f32x4){sg[r32], sg[32 + r32], sg[64 + r32], sg[96 + r32]};
                            bf16_t* Ow = opaque(OB) + (rb + q0 + wave * 32) * DM + h * 128 + r32;
#pragma unroll
                            for (int r = 0; r < 16; ++r) { float v[4]; float ss = 0.f;
#pragma unroll
                                for (int d0 = 0; d0 < 4; ++d0) { v[d0] = st[(d0 * 16 + r) * 512] - lam * (o[d0][r] * rl[r]); ss += v[d0] * v[d0]; }
                                ss = lane_xor_add<1>(ss); ss = lane_xor_add<2>(ss); ss = lane_xor_add<4>(ss); ss = lane_xor_add<8>(ss); ss = lane_xor_add<16>(ss);
                                const float rinv = (1.0f - LAM_INIT_C) / sqrtf(ss * (1.0f / 128.0f) + RMS_EPS); const int orow = att::crow(r, hh);
#pragma unroll
                                for (int d0 = 0; d0 < 4; ++d0) Ow[(size_t)orow * DM + d0 * 32] = (bf16_t)(cvt_pk_bf16(v[d0] * rinv * gv[d0], 0.f) & 0xffffu);
                                if ((r & 3) == 3) asm volatile("" ::: "memory"); }
                        }
                    }
                }
            } }
            SEAM(P + 1);
        }
        if (EN(4) && IN(P + 2)) { REP(6) {
            DenseSched S; S.init(WSP(bf16_t, WS_O), WSP(bf16_t, WS_WO) + (size_t)l * 1024 * 1024, 1024, lastl ? 64 : 72, 4, G, bx, lastl ? 1 : 0);
            EpiWo E{WSP(float, WS_X), WSP(float, WS_Y), MODL};
            pg8::gemm_phase(ring, 1024, S, E);
            if (rep_ == 0) DRAIN(l, -1); }
            SEAM(P + 2);
        }
        if (EN(5) && IN(P + 3)) { REP(9) {
            const float* lg = opaque(args.in[6] + (size_t)(l * 2 + 0) * 1024); const float* lb = opaque(args.in[7] + (size_t)(l * 2 + 0) * 1024);
            const float* wr = WSP(float, WS_WR) + (size_t)l * 36 * 1024; const float* bg = opaque(args.in[23] + l * 4); const float* be = opaque(args.in[25] + l * 32);
            float* X = WSP(float, WS_X); float* Y = WSP(float, WS_Y); bf16_t* HB = WSP(bf16_t, WS_HB); const float* modl = MODL; u32x4* TOK = WSP(u32x4, WS_TOK); int* LIST = WSP(int, WS_LIST); unsigned* cnt = CNTL;
            PHASE_TID();
            LAS unsigned* RI = (LAS unsigned*)(lds + RI_OFF); LAS unsigned* lc = RI + 128 * 8; LAS unsigned* gb = lc + 32;
            LAS float* WL = (LAS float*)ring;
            __syncthreads();
            if (tid < 128) RI[tid * 8] = 0xffffffffu; if (tid < 32) lc[tid] = 0u;
            for (int i = tid; i < 36 * 256; i += 512) ((LAS f32x4*)WL)[i] = ((const f32x4*)wr)[i];
            __syncthreads();
            constexpr int RB = 3;
            int nslot = wave * 16;
            const int RPW = MROWS / NGW;
            const int rend = (gw + 1) * RPW;
#define ROWC(r) ((((r) < rend) && !(lastl && ((r) % TPB) >= SEQ)) ? (r) : 0)
            f32x4 y[RB][4], yn[RB][4];
#pragma unroll
            for (int k = 0; k < RB; ++k) { const int rc = ROWC(gw * RPW + k);
#pragma unroll
                for (int j = 0; j < 4; ++j) y[k][j] = *(const f32x4*)(Y + (size_t)rc * DM + 4 * lane + 256 * j); }
            for (int r0 = gw * RPW; r0 < rend; r0 += RB, nslot += RB) {
                int row[RB]; bool ok[RB]; const float* mv[RB];
#pragma unroll
                for (int k = 0; k < RB; ++k) { const int r = r0 + k; const int t = r % TPB; ok[k] = (r < rend) && !(lastl && t >= SEQ); row[k] = ok[k] ? r : 0;
                    const int b = row[k] / TPB; mv[k] = modl + (size_t)(((row[k] % TPB) >= SEQ) ? 8 : b) * 6144; }
#pragma unroll
                for (int k = 0; k < RB; ++k) { const int rc = ROWC(r0 + RB + k);
#pragma unroll
                    for (int j = 0; j < 4; ++j) yn[k][j] = *(const f32x4*)(Y + (size_t)rc * DM + 4 * lane + 256 * j); }
                float s[RB];
#pragma unroll
                for (int k = 0; k < RB; ++k) { s[k] = 0.f;
#pragma unroll
                    for (int j = 0; j < 4; ++j) s[k] += (y[k][j][0] + y[k][j][1]) + (y[k][j][2] + y[k][j][3]); }
                float s2[RB];
#pragma unroll
                for (int k = 0; k < RB; ++k) { const float mean = wave_sum(s[k]) * (1.0f / 1024.0f); s2[k] = 0.f;
#pragma unroll
                    for (int j = 0; j < 4; ++j) { y[k][j] = y[k][j] - mean; s2[k] += (y[k][j][0] * y[k][j][0] + y[k][j][1] * y[k][j][1]) + (y[k][j][2] * y[k][j][2] + y[k][j][3] * y[k][j][3]); } }
                float rstd[RB];
#pragma unroll
                for (int k = 0; k < RB; ++k) rstd[k] = 1.0f / sqrtf(wave_sum(s2[k]) * (1.0f / 1024.0f) + LN_EPS);
#pragma unroll
                for (int j = 0; j < 4; ++j) { const int c = 4 * lane + 256 * j; const f32x4 gq = *(const f32x4*)(lg + c), bq = *(const f32x4*)(lb + c);
#pragma unroll
                    for (int k = 0; k < RB; ++k) {
                        const f32x4 xn = y[k][j] * rstd[k] * gq + bq;
                        const f32x4 hv = xn * (*(const f32x4*)(mv[k] + 4096 + c) + 1.0f) + *(const f32x4*)(mv[k] + 3072 + c);
                        y[k][j] = hv;
                        if (ok[k]) { *(f32x4*)(X + (size_t)row[k] * DM + c) = xn;
                            u32x2 w; w.x = cvt_pk_bf16(hv[0], hv[1]); w.y = cvt_pk_bf16(hv[2], hv[3]); *(u32x2*)(HB + (size_t)row[k] * DM + c) = w; } } }
                float gl[RB][4];
#pragma unroll
                for (int e = 0; e < 4; ++e) { float p[RB];
#pragma unroll
                    for (int k = 0; k < RB; ++k) p[k] = 0.f;
#pragma unroll
                    for (int j = 0; j < 4; ++j) { const f32x4 w = *(const LAS f32x4*)(WL + e * 1024 + 4 * lane + 256 * j);
#pragma unroll
                        for (int k = 0; k < RB; ++k) p[k] += (y[k][j][0] * w[0] + y[k][j][1] * w[1]) + (y[k][j][2] * w[2] + y[k][j][3] * w[3]); }
#pragma unroll
                    for (int k = 0; k < RB; ++k) gl[k][e] = wave_sum(p[k]) + bg[e]; }
                int gsel[RB]; float gprob[RB];
#pragma unroll
                for (int k = 0; k < RB; ++k) { gsel[k] = 0; float gmax = gl[k][0];
#pragma unroll
                    for (int e = 1; e < 4; ++e) if (gl[k][e] > gmax) { gmax = gl[k][e]; gsel[k] = e; }
                    float gden = 0.f;
#pragma unroll
                    for (int e = 0; e < 4; ++e) gden += expf(gl[k][e] - gmax);
                    gprob[k] = 1.0f / gden; }
                float el[RB][8];
#pragma unroll
                for (int k = 0; k < RB; ++k) { const LAS float* wp0 = WL + (4 + gsel[k] * 8) * 1024 + 4 * lane;
#pragma unroll
                    for (int e = 0; e < 8; ++e) { float p = 0.f;
#pragma unroll
                        for (int j = 0; j < 4; ++j) { const f32x4 w = *(const LAS f32x4*)(wp0 + e * 1024 + 256 * j); p += (y[k][j][0] * w[0] + y[k][j][1] * w[1]) + (y[k][j][2] * w[2] + y[k][j][3] * w[3]); }
                        el[k][e] = p; } }
#pragma unroll
                for (int k = 0; k < RB; ++k)
#pragma unroll
                    for (int e = 0; e < 8; ++e) el[k][e] = wave_sum(el[k][e]) + be[gsel[k] * 8 + e];
#pragma unroll
                for (int k = 0; k < RB; ++k) {
                    int i1 = 0; float v1 = el[k][0];
#pragma unroll
                    for (int e = 1; e < 8; ++e) if (el[k][e] > v1) { v1 = el[k][e]; i1 = e; }
                    int i2 = -1; float v2 = -3.0e38f;
#pragma unroll
                    for (int e = 0; e < 8; ++e) if (e != i1 && el[k][e] > v2) { v2 = el[k][e]; i2 = e; }
                    const float ex = expf(v2 - v1), w1 = gprob[k] / (1.0f + ex), w2 = gprob[k] * ex / (1.0f + ex);
                    if (lane == 0 && ok[k]) {
                        const int e1 = gsel[k] * 8 + i1, e2 = gsel[k] * 8 + i2;
                        const unsigned p1 = __hip_atomic_fetch_add(lc + e1, 1u, __ATOMIC_RELAXED, __HIP_MEMORY_SCOPE_WORKGROUP), p2 = __hip_atomic_fetch_add(lc + e2, 1u, __ATOMIC_RELAXED, __HIP_MEMORY_SCOPE_WORKGROUP);
                        LAS unsigned* ri = RI + (nslot + k) * 8;
                        ri[0] = (unsigned)row[k]; ri[1] = (unsigned)e1 | (p1 << 8); ri[2] = __float_as_uint(w1); ri[3] = (unsigned)e2 | (p2 << 8); ri[4] = __float_as_uint(w2);
                    }
                }
#pragma unroll
                for (int k = 0; k < RB; ++k)
#pragma unroll
                    for (int j = 0; j < 4; ++j) y[k][j] = yn[k][j];
            }
#undef ROWC
            __syncthreads();
            if (tid < 32 && rep_ == 0) { const unsigned n = lc[tid]; gb[tid] = n ? atomicAdd(cnt + tid * 64, n) : 0u; }
            __syncthreads();
            if (tid < 128 && rep_ == 0) { const unsigned r = RI[tid * 8];
                if (r != 0xffffffffu) { const unsigned a1 = RI[tid * 8 + 1], a2 = RI[tid * 8 + 3]; const unsigned e1 = a1 & 255u, e2 = a2 & 255u, p1 = gb[e1] + (a1 >> 8), p2 = gb[e2] + (a2 >> 8);
                    LIST[(size_t)e1 * MROWS + p1] = (int)r; LIST[(size_t)e2 * MROWS + p2] = (int)r;
                    TOK[r] = (u32x4){e1 | (p1 << 8), RI[tid * 8 + 2], e2 | (p2 << 8), RI[tid * 8 + 4]}; }
            } }
            SEAM(P + 3);
        }
        if (IN(P + 4) || IN(P + 5) || IN(P + 6)) {
            PHASE_TID();
            __syncthreads();
            if (tid < 32) tab[tid] = (int)__hip_atomic_load((GAS unsigned*)CNTL + tid * 64, RLX_AGENT);
            __syncthreads();
            if (tid == 0) { int p = 0; for (int e = 0; e < 32; ++e) { tab[32 + e] = p; p += (tab[e] + 255) >> 8; } tab[64] = p; }
            __syncthreads();
        }
        if (EN(6) && IN(P + 4)) { REP(7) {
            MoeGuSched S{(const char*)WSP(bf16_t, WS_HB), (const char*)(WSP(bf16_t, WS_WGU) + (size_t)l * 32 * 1024 * 1024), WSP(int, WS_LIST), tab, G, vcu};
            EpiGU E{WSP(bf16_t, WS_HID)};
            pg8::gemm_phase(ring, 1024, S, E);
            if (rep_ == 0 && !lastl) { const int nwg = 4 * tab[64], mx = (nwg + G - 1) / G, mine = (nwg > vcu) ? (nwg - vcu + G - 1) / G : 0; if (mine < mx) DRAIN(l + 1, (mx - mine) * PULLS_PER_UNIT); } }
            SEAM(P + 4);
        }
        if (EN(6) && IN(P + 5)) { REP(8) {
            MoeDownSched S{(const char*)WSP(bf16_t, WS_HID), (const char*)(WSP(bf16_t, WS_WD) + (size_t)l * 32 * 1024 * 512), tab, G, vcu};
            EpiDown E{WSP(bf16_t, WS_YS)};
            pg8::gemm_phase(ring, 512, S, E);
            if (rep_ == 0 && !lastl) { const int nwg = 4 * tab[64], mx = (nwg + G - 1) / G, mine = (nwg > vcu) ? (nwg - vcu + G - 1) / G : 0; if (mine < mx) DRAIN(l + 1, (mx - mine) * (PULLS_PER_UNIT / 2)); } }
            SEAM(P + 5);
        }
        if (EN(5) && IN(P + 6)) { REP(10) {
            const float* lg = opaque(args.in[6] + (size_t)(l * 2 + 1) * 1024); const float* lb = opaque(args.in[7] + (size_t)(l * 2 + 1) * 1024);
            float* X = WSP(float, WS_X); bf16_t* HB = WSP(bf16_t, WS_HB); const float* modl = MODL; u32x4* TOK = WSP(u32x4, WS_TOK); bf16_t* YS = WSP(bf16_t, WS_YS); float* MOD = WSP(float, WS_MOD); float* outp = opaque(args.out);
            float* Xo = rep_ ? WSP(float, WS_Y) : X; bf16_t* HBo = rep_ ? WSP(bf16_t, WS_STASH) : HB; if (rep_) outp = WSP(float, WS_Y);
            PHASE_TID();
            constexpr int RB = 3;
            const int RPW = MROWS / NGW;
            LAS float* VL = (LAS float*)ring;
            { const int bwg = (gw * RPW) / TPB; const int ln = lastl ? l : l + 1;
              __syncthreads();
              for (int i = tid; i < 8 * 256; i += 512) { const int v = i >> 8, c4 = (i & 255) * 4; const float* src;
                  if (v == 0) src = lg; else if (v == 1) src = lb; else { const int bb = (v < 5) ? bwg : 8, q = (v - 2) % 3;
                      src = (q == 0) ? modl + (size_t)bb * 6144 + 5120 : MOD + ((size_t)ln * 9 + bb) * 6144 + (q == 1 ? 0 : 1024); }
                  *(LAS f32x4*)(VL + v * 1024 + c4) = *(const f32x4*)(src + c4); }
              __syncthreads(); }
            const int rbase = bx * 8 * RPW, rbeg = gw * RPW, rend = rbeg + RPW;
#define ROWC(r) ((((r) < rend) && !(lastl && ((r) % TPB) >= SEQ)) ? (r) : 0)
            LAS u32x4* TK = (LAS u32x4*)(VL + 8 * 1024);
            if (tid < 8 * RPW) { const int r = rbase + tid; const int rc = (lastl && (r % TPB) >= SEQ) ? 0 : r; TK[tid] = TOK[rc]; }
            __syncthreads();
#define P7_LOAD(XR, AR, BR, W1, W2, R0) do { _Pragma("unroll") for (int k = 0; k < RB; ++k) { const int r_ = (R0) + k, rc_ = ROWC(r_); const u32x4 tk = TK[(r_ < rend ? r_ : rbeg) - rbase]; \
                const int e1 = tk.x & 255, p1 = tk.x >> 8, e2 = tk.z & 255, p2 = tk.z >> 8; W1[k] = __uint_as_float(tk.y); W2[k] = __uint_as_float(tk.w); \
                const bf16_t* ya_ = YS + ((size_t)tab[32 + e1] * 256 + p1) * DM; const bf16_t* yb_ = YS + ((size_t)tab[32 + e2] * 256 + p2) * DM; \
                _Pragma("unroll") for (int j = 0; j < 4; ++j) { const int c = 4 * lane + 256 * j; XR[k][j] = *(const f32x4*)(X + (size_t)rc_ * DM + c); AR[k][j] = *(const u32x2*)(ya_ + c); BR[k][j] = *(const u32x2*)(yb_ + c); } } } while (0)
            f32x4 xr[RB][4], xn_[RB][4]; u32x2 ar[RB][4], br[RB][4], an_[RB][4], bn_[RB][4]; float w1[RB], w2[RB], w1n[RB], w2n[RB];
            P7_LOAD(xr, ar, br, w1, w2, rbeg);
            for (int r0 = rbeg; r0 < rend; r0 += RB) {
                int row[RB]; bool ok[RB]; int bbk[RB];
#pragma unroll
                for (int k = 0; k < RB; ++k) { const int r = r0 + k; const int t = r % TPB; ok[k] = (r < rend) && !(lastl && t >= SEQ); row[k] = ok[k] ? r : 0;
                    bbk[k] = ((row[k] % TPB) >= SEQ) ? 5 : 2; }
                P7_LOAD(xn_, an_, bn_, w1n, w2n, r0 + RB);
                f32x4 y[RB][4]; float s[RB];
#pragma unroll
                for (int k = 0; k < RB; ++k) { s[k] = 0.f; const LAS float* g2 = VL + bbk[k] * 1024;
#pragma unroll
                    for (int j = 0; j < 4; ++j) { const int c = 4 * lane + 256 * j;
                        const u32x2 a = ar[k][j], bq = br[k][j];
                        f32x4 f; f[0] = w1[k] * __uint_as_float(a.x << 16) + w2[k] * __uint_as_float(bq.x << 16); f[1] = w1[k] * __uint_as_float(a.x & 0xffff0000u) + w2[k] * __uint_as_float(bq.x & 0xffff0000u);
                        f[2] = w1[k] * __uint_as_float(a.y << 16) + w2[k] * __uint_as_float(bq.y << 16); f[3] = w1[k] * __uint_as_float(a.y & 0xffff0000u) + w2[k] * __uint_as_float(bq.y & 0xffff0000u);
                        y[k][j] = xr[k][j] * ALPHA + *(const LAS f32x4*)(g2 + c) * f;
                        s[k] += (y[k][j][0] + y[k][j][1]) + (y[k][j][2] + y[k][j][3]); } }
                float s2[RB];
#pragma unroll
                for (int k = 0; k < RB; ++k) { const float mean = wave_sum(s[k]) * (1.0f / 1024.0f); s2[k] = 0.f;
#pragma unroll
                    for (int j = 0; j < 4; ++j) { y[k][j] = y[k][j] - mean; s2[k] += (y[k][j][0] * y[k][j][0] + y[k][j][1] * y[k][j][1]) + (y[k][j][2] * y[k][j][2] + y[k][j][3] * y[k][j][3]); } }
                float rstd[RB];
#pragma unroll
                for (int k = 0; k < RB; ++k) rstd[k] = 1.0f / sqrtf(wave_sum(s2[k]) * (1.0f / 1024.0f) + LN_EPS);
#pragma unroll
                for (int j = 0; j < 4; ++j) { const int c = 4 * lane + 256 * j; const f32x4 gq = *(const LAS f32x4*)(VL + c), bq = *(const LAS f32x4*)(VL + 1024 + c);
#pragma unroll
                    for (int k = 0; k < RB; ++k) { if (!ok[k]) continue;
                        const f32x4 xn = y[k][j] * rstd[k] * gq + bq;
                        if (!lastl) { *(f32x4*)(Xo + (size_t)row[k] * DM + c) = xn;
                            const LAS float* mvn = VL + (bbk[k] + 1) * 1024;
                            const f32x4 hv = xn * (*(const LAS f32x4*)(mvn + 1024 + c) + 1.0f) + *(const LAS f32x4*)(mvn + c);
                            u32x2 w; w.x = cvt_pk_bf16(hv[0], hv[1]); w.y = cvt_pk_bf16(hv[2], hv[3]); *(u32x2*)(HBo + (size_t)row[k] * DM + c) = w; }
                        else { const int b = row[k] / TPB, t = row[k] % TPB; *(f32x4*)(outp + ((size_t)b * SEQ + t) * DM + c) = xn; } } }
#pragma unroll
                for (int k = 0; k < RB; ++k) { w1[k] = w1n[k]; w2[k] = w2n[k];
#pragma unroll
                    for (int j = 0; j < 4; ++j) { xr[k][j] = xn_[k][j]; ar[k][j] = an_[k][j]; br[k][j] = bn_[k][j]; } }
            }
#undef ROWC
#undef P7_LOAD
            }
            SEAM(P + 6);
        }
    }
#undef IN
#undef SEAM
}

extern "C" void kernel_launch(void* const* d_in, const int* in_sizes, int n_in, void* d_out, int out_size, void* d_ws, size_t ws_size, hipStream_t stream) {
    static int grid = 0;
    if (grid == 0) {
        if (n_in != 29 || in_sizes[0] != NB * SEQ * DM || out_size != NB * SEQ * DM || ws_size < WS_END) { fprintf(stderr, "kernel_launch: unexpected shapes / workspace (n_in %d, ws %zu)\n", n_in, ws_size); grid = -1; return; }
        int dev = 0, cus = 0, per_cu = 0;
        if (hipGetDevice(&dev) != hipSuccess || hipDeviceGetAttribute(&cus, hipDeviceAttributeMultiprocessorCount, dev) != hipSuccess) { grid = -1; return; }
        if (hipFuncSetAttribute((const void*)fwd, hipFuncAttributeMaxDynamicSharedMemorySize, LDS_BYTES) != hipSuccess) { fprintf(stderr, "kernel_launch: hipFuncSetAttribute failed\n"); grid = -1; return; }
        if (hipOccupancyMaxActiveBlocksPerMultiprocessor(&per_cu, (const void*)fwd, 512, LDS_BYTES) != hipSuccess || per_cu < 1) fprintf(stderr, "kernel_launch: occupancy query says %d\n", per_cu);
        (void)hipGetLastError();
        grid = cus;
    }
    if (grid < 0) return;
    if (hipMemsetAsync((char*)d_ws + WS_CTL, 0, CTL_ZERO_BYTES, stream) != hipSuccess) return;
    Args a{};
    for (int i = 0; i < 29; ++i) a.in[i] = (const float*)d_in[i];
    a.out = (float*)d_out; a.ws = (unsigned char*)d_ws;
    if (MK_N_LAUNCHES == 1) { a.ph_lo = 0; a.ph_hi = NPHASE; hipLaunchKernelGGL(fwd, dim3(grid), dim3(512), LDS_BYTES, stream, a); }
    else for (int p = 0; p < NPHASE; ++p) { a.ph_lo = p; a.ph_hi = p + 1; hipLaunchKernelGGL(fwd, dim3(grid), dim3(512), LDS_BYTES, stream, a); }
    const hipError_t le = hipPeekAtLastError();
    if (le != hipSuccess) fprintf(stderr, "kernel_launch: launch failed: %s\n", hipGetErrorName(le));
}
```

```cpp
#include <hip/hip_runtime.h>
#include <hip/hip_bf16.h>
#include <cstdio>
#include <cstdint>

#define PSEL 0
#ifndef MK_N_LAUNCHES
#define MK_N_LAUNCHES 1
#endif

#define LAS __attribute__((address_space(3)))
#define GAS __attribute__((address_space(1)))
typedef unsigned short bf16_t;
typedef short bf16x8 __attribute__((ext_vector_type(8)));
typedef short s16x4 __attribute__((ext_vector_type(4)));
typedef float f32x2 __attribute__((ext_vector_type(2)));
typedef float f32x4 __attribute__((ext_vector_type(4)));
typedef float f32x16 __attribute__((ext_vector_type(16)));
typedef unsigned u32x2 __attribute__((ext_vector_type(2)));
typedef unsigned u32x4 __attribute__((ext_vector_type(4)));

constexpr int DM = 1024, NB = 8, SEQ = 2048, CTXL = 256, TPB = SEQ + CTXL, MROWS = NB * TPB;
constexpr int DEPTH = 4, NEXP = 32, EFF = 512;
constexpr float ALPHA = 1.6817928305074292f;
constexpr float LN_EPS = 1e-5f, RMS_EPS = 1e-6f;
constexpr float LAM_INIT_C = 0.47071301834358416f;
constexpr int KSPLIT = 16;

constexpr size_t MiB = 1u << 20;
constexpr size_t WS_CTL = 0, CTL_ZERO_BYTES = 1 * MiB;
constexpr size_t WS_MOD = 1 * MiB;
constexpr size_t WS_ROPE = 2 * MiB;
constexpr size_t WS_WR = 2 * MiB + 64 * 1024;
constexpr size_t WS_PART = 3 * MiB;
constexpr size_t WS_TOK = 17 * MiB;
constexpr size_t WS_LIST = 18 * MiB;
constexpr size_t WS_WQKV = 21 * MiB;
constexpr size_t WS_WO = 36 * MiB;
constexpr size_t WS_WGU = 44 * MiB;
constexpr size_t WS_WD = 300 * MiB;
constexpr size_t WS_X = 428 * MiB;
constexpr size_t WS_Y = 500 * MiB;
constexpr size_t WS_HB = 572 * MiB;
constexpr size_t WS_QKV = 608 * MiB;
constexpr size_t WS_O = 716 * MiB;
constexpr size_t WS_HID = WS_QKV;
constexpr size_t WS_YS = 652 * MiB;
constexpr size_t WS_STASH = 752 * MiB;
constexpr size_t WS_END = 784 * MiB;
constexpr int MAXSLOT = 45056;
constexpr int CW_TMO = 0, CW_CODE = 1, CW_BAR = 4096, CW_CNT = 8192;

constexpr int MISC_OFF = 0;
constexpr int RING_OFF = 512, RING_BYTES = 131072;
constexpr int SS_OFF = RING_OFF + RING_BYTES;
constexpr int TAB_OFF = SS_OFF + 16384;
constexpr int RI_OFF = TAB_OFF + 1024;
constexpr int LDS_BYTES = RI_OFF + 4096 + 256;

#define RLX_AGENT __ATOMIC_RELAXED, __HIP_MEMORY_SCOPE_AGENT
template <class T> __device__ __forceinline__ T* opaque(T* p) { size_t z = 0; asm volatile("" : "+s"(z)); return (T*)((char*)p + z); }
__device__ __forceinline__ unsigned cvt_pk_bf16(float lo, float hi) { unsigned r; asm volatile("v_cvt_pk_bf16_f32 %0, %1, %2" : "=v"(r) : "v"(lo), "v"(hi)); return r; }
__device__ __forceinline__ float bf2f(unsigned short h) { return __uint_as_float(((unsigned)h) << 16); }
template <int M> __device__ __forceinline__ float lane_xor_add(float v) {
    if constexpr (M == 32) { auto rr = __builtin_amdgcn_permlane32_swap(__float_as_uint(v), __float_as_uint(v), false, false); return __uint_as_float(rr[0]) + __uint_as_float(rr[1]); }
    else return v + __int_as_float(__builtin_amdgcn_ds_swizzle(__float_as_int(v), (M << 10) | 0x1f));
}
__device__ __forceinline__ float wave_sum(float v) {
    v = lane_xor_add<1>(v); v = lane_xor_add<2>(v); v = lane_xor_add<4>(v); v = lane_xor_add<8>(v); v = lane_xor_add<16>(v); v = lane_xor_add<32>(v);
    return v;
}

#define XB_TMO      128
#define XB_XCNT(j)  (256  + 64 * (j))
#define XB_XSUB(j)  (1280 + 64 * (j))
#define XB_XGEN(j)  (2304 + 64 * (j))
#define XB_TOP      3328
#define XB_TOPGEN   3392
#define XCD_BAR_WORDS 3456
#define XB_SPIN_CAP (1u << 18)
__device__ __forceinline__ unsigned xb_ld(unsigned* p)              { return __hip_atomic_load(p, __ATOMIC_RELAXED, __HIP_MEMORY_SCOPE_AGENT); }
__device__ __forceinline__ unsigned xb_add(unsigned* p, unsigned v) { return __hip_atomic_fetch_add(p, v, __ATOMIC_RELAXED, __HIP_MEMORY_SCOPE_AGENT); }
__device__ __forceinline__ unsigned xb_xcc_id() { return (unsigned)__builtin_amdgcn_s_getreg((3 << 11) | 20) & 0xFu; }
#define XB_SPIN(cond, bar) do { unsigned _sp = 0; while (cond) { __builtin_amdgcn_s_sleep(1); \
    if ((++_sp & 255u) == 0u) { if (xb_ld(&(bar)[XB_TMO])) break; if (_sp > XB_SPIN_CAP) { atomicAdd(&(bar)[XB_TMO], 1u); break; } } } } while (0)
struct XcdBarrier { unsigned* bar; unsigned x; volatile LAS unsigned* st; };
__device__ __forceinline__ XcdBarrier xcd_barrier_post(unsigned* bar, volatile LAS unsigned* st) {
    XcdBarrier b; b.bar = bar; b.x = xb_xcc_id(); b.st = st;
    if (threadIdx.x == 0) (void)xb_add(&bar[XB_XCNT(b.x)], 1u);
    return b;
}
__device__ __forceinline__ void xcd_barrier_complete(unsigned* bar, unsigned x, unsigned& nloc, unsigned& nx) {
    const unsigned G = gridDim.x * gridDim.y * gridDim.z;
    unsigned sum, cnt, mine, sp = 0u;
    for (;;) {
        sum = 0u; cnt = 0u; mine = 0u;
#pragma unroll
        for (unsigned j = 0; j < 16; ++j) { const unsigned c = xb_ld(&bar[XB_XCNT(j)]); sum += c; cnt += (c > 0u) ? 1u : 0u; mine = (j == x) ? c : mine; }
        if (sum == G) break;
        __builtin_amdgcn_s_sleep(1);
        if ((++sp & 255u) == 0u) { if (xb_ld(&bar[XB_TMO])) break; if (sp > XB_SPIN_CAP) { atomicAdd(&bar[XB_TMO], 1u); break; } }
    }
    nloc = mine > 0u ? mine : 1u; nx = cnt > 0u ? cnt : 1u;
}
__device__ __forceinline__ void xcd_barrier(const XcdBarrier& b) {
    asm volatile("s_waitcnt vmcnt(0)" ::: "memory");
    __syncthreads();
    if (threadIdx.x == 0) {
        unsigned* bar = b.bar;
        __builtin_amdgcn_s_waitcnt(0);
        unsigned nloc = b.st[0], nx = b.st[1];
        if (nloc == 0u) { xcd_barrier_complete(bar, b.x, nloc, nx); b.st[0] = nloc; b.st[1] = nx; }
        const unsigned old = xb_add(&bar[XB_XSUB(b.x)], 1u);
        const unsigned gen = old / nloc;
        if (old + 1u == (gen + 1u) * nloc) {
            __builtin_amdgcn_fence(__ATOMIC_RELEASE, "agent");
            asm volatile("s_waitcnt vmcnt(0)" ::: "memory");
            const unsigned og = xb_add(&bar[XB_TOP], 1u);
            const unsigned tg = og / nx;
            if (og + 1u == (tg + 1u) * nx) xb_add(&bar[XB_TOPGEN], 1u);
            else XB_SPIN(xb_ld(&bar[XB_TOPGEN]) == tg, bar);
            __builtin_amdgcn_fence(__ATOMIC_ACQUIRE, "agent");
            xb_add(&bar[XB_XGEN(b.x)], 1u);
            asm volatile("s_waitcnt vmcnt(0)" ::: "memory");
        } else {
            XB_SPIN(xb_ld(&bar[XB_XGEN(b.x)]) == gen, bar);
            __builtin_amdgcn_fence(__ATOMIC_ACQUIRE, "agent");
            asm volatile("s_waitcnt vmcnt(0)" ::: "memory");
        }
    }
    __syncthreads();
}

namespace pg8 {
constexpr int BM = 256, BK = 64, HALF = 128, HTB = HALF * BK * 2, STAGE_BYTES = 8 * HTB;
__device__ __forceinline__ int lds_byte(int r, int c) { const int st = (r >> 4) * 2 + (c >> 5), rr = r & 15, cc = c & 31, ob = rr * 64 + cc * 2; return st * 1024 + (ob ^ (((ob >> 9) & 1) << 5)); }
__device__ __forceinline__ void stage_rc(int b, int& R, int& C) { const int st = b / 1024, sb = b % 1024, swz = sb ^ (((sb >> 9) & 1) << 5); R = (st >> 1) * 16 + swz / 64; C = (st & 1) * 32 + (swz % 64) / 2; }
struct Unit { int pm, pn, e, nrow; };

template <class Epi, class Sched>
__device__ __forceinline__ void gemm_phase(LAS unsigned char* lds, const int K, const Sched& S, const Epi& E) {
    int tid = threadIdx.x; asm volatile("" : "+v"(tid));
    const int wid = __builtin_amdgcn_readfirstlane(tid >> 6), lane = tid & 63, wr = wid >> 2, wc = wid & 3, fr = lane & 15, fq = lane >> 4;
    const int nt = K / BK;
    unsigned voffB[2];
#pragma unroll
    for (int i = 0; i < 2; ++i) { int R_, C_; stage_rc(tid * 16 + i * 8192, R_, C_); voffB[i] = (unsigned)(R_ * K + C_) * 2u; }
    const size_t kstep = (size_t)(BK * 2);
    const size_t hstepB = (size_t)HALF * K * 2;
    const unsigned ldsw = (unsigned)wid * 1024u;
    const int aoff = lds_byte(wr * 64 + fr, fq * 8), boff = lds_byte(wc * 32 + fr, fq * 8);
#define PG8_SA(b, h) (((b) * 2 + (h)) * HTB)
#define PG8_SB(b, h) ((4 + (b) * 2 + (h)) * HTB)
#define PG8_STAGE(bufoff, gbase, voff) do { _Pragma("unroll") for (int _i = 0; _i < 2; ++_i) \
        __builtin_amdgcn_global_load_lds((const unsigned*)((const char*)(gbase) + (voff)[_i]), (LAS unsigned*)(lds + (bufoff) + ldsw + _i * 8192), 16, 0, 0); } while (0)
#define PG8_LDA(dst, b, h) do { _Pragma("unroll") for (int m = 0; m < 4; ++m) _Pragma("unroll") for (int k = 0; k < 2; ++k) dst[m][k] = *(const LAS bf16x8*)(lds + PG8_SA(b, h) + aoff + m * 2048 + k * 1024); } while (0)
#define PG8_LDB(dst, b, h) do { _Pragma("unroll") for (int n = 0; n < 2; ++n) _Pragma("unroll") for (int k = 0; k < 2; ++k) dst[n][k] = *(const LAS bf16x8*)(lds + PG8_SB(b, h) + boff + n * 2048 + k * 1024); } while (0)
#define PG8_MMA(ai, bj, At, Bt) do { __builtin_amdgcn_s_setprio(1); _Pragma("unroll") for (int m = 0; m < 4; ++m) _Pragma("unroll") for (int n = 0; n < 2; ++n) _Pragma("unroll") for (int k = 0; k < 2; ++k) \
        acc[ai][bj][m][n] = __builtin_amdgcn_mfma_f32_16x16x32_bf16(Bt[n][k], At[m][k], acc[ai][bj][m][n], 0, 0, 0); __builtin_amdgcn_s_setprio(0); } while (0)
#define PG8_WAIT_V(n) asm volatile("s_waitcnt vmcnt(" #n ")" ::: "memory")
#define PG8_WAIT_L(n) asm volatile("s_waitcnt lgkmcnt(" #n ")" ::: "memory")
#define PG8_BAR __builtin_amdgcn_s_barrier()
#define PG8_SCHED __builtin_amdgcn_sched_barrier(0)
    Unit cur, nxt; int ui = 0;
    if (!S.next(0, cur)) return;
    f32x4 acc[2][2][4][2];
#pragma unroll
    for (int a = 0; a < 2; ++a)
#pragma unroll
        for (int b = 0; b < 2; ++b)
#pragma unroll
            for (int m = 0; m < 4; ++m)
#pragma unroll
                for (int n = 0; n < 2; ++n) acc[a][b][m][n] = (f32x4){0.f, 0.f, 0.f, 0.f};
    bf16x8 At[4][2], B0[2][2], B1[2][2];
    unsigned vA0[2], vA1[2], nA0[2], nA1[2];
    S.a_voff(cur, tid, K, vA0, vA1);
    const char* cA = S.a_ptr(cur); const char* cB = S.b_ptr(cur);
    PG8_STAGE(PG8_SB(0, 0), cB, voffB); PG8_STAGE(PG8_SB(0, 1), cB + hstepB, voffB); PG8_STAGE(PG8_SA(0, 0), cA, vA0); PG8_STAGE(PG8_SA(0, 1), cA, vA1);
    if (wr == 1) PG8_BAR;
    PG8_WAIT_V(2); PG8_BAR;
    PG8_STAGE(PG8_SB(1, 0), cB + kstep, voffB); PG8_STAGE(PG8_SA(1, 0), cA + kstep, vA0); PG8_STAGE(PG8_SB(1, 1), cB + hstepB + kstep, voffB);
    PG8_WAIT_V(6); PG8_BAR;
    for (;;) {
        const bool has_next = S.next(ui + 1, nxt);
        const char* nA = cA; const char* nB = cB;
#pragma unroll
        for (int i = 0; i < 2; ++i) { nA0[i] = vA0[i]; nA1[i] = vA1[i]; }
        if (has_next) { nA = S.a_ptr(nxt); nB = S.b_ptr(nxt); S.a_voff(nxt, tid, K, nA0, nA1); }
        for (int t = 0; t < nt; t += 2) {
            const bool last = (t == nt - 2);
            const char* a1 = cA + (size_t)(t + 1) * kstep;
            const char* a2 = last ? nA : cA + (size_t)(t + 2) * kstep; const char* b2 = last ? nB : cB + (size_t)(t + 2) * kstep;
            const char* a3 = a2 + kstep; const char* b3 = b2 + kstep;
            PG8_LDB(B0, 0, 0); PG8_LDB(B1, 0, 1); PG8_SCHED; PG8_LDA(At, 0, 0); PG8_STAGE(PG8_SA(1, 1), a1, vA1);
            if (last) {
#pragma unroll
                for (int i = 0; i < 2; ++i) { vA0[i] = nA0[i]; vA1[i] = nA1[i]; } }
            PG8_WAIT_V(8); PG8_WAIT_L(0); PG8_BAR; PG8_MMA(0, 0, At, B0); PG8_MMA(0, 1, At, B1); PG8_BAR; PG8_SCHED;
            PG8_LDA(At, 0, 1); PG8_STAGE(PG8_SB(0, 0), b2, voffB); PG8_STAGE(PG8_SB(0, 1), b2 + hstepB, voffB); PG8_STAGE(PG8_SA(0, 0), a2, vA0);
            PG8_WAIT_V(8); PG8_WAIT_L(0); PG8_BAR; PG8_MMA(1, 0, At, B0); PG8_MMA(1, 1, At, B1); PG8_BAR; PG8_SCHED;
            PG8_LDB(B0, 1, 0); PG8_LDB(B1, 1, 1); PG8_SCHED; PG8_LDA(At, 1, 0); PG8_STAGE(PG8_SA(0, 1), a2, vA1);
            PG8_WAIT_V(8); PG8_WAIT_L(0); PG8_BAR; PG8_MMA(0, 0, At, B0); PG8_MMA(0, 1, At, B1); PG8_BAR; PG8_SCHED;
            PG8_LDA(At, 1, 1); PG8_STAGE(PG8_SB(1, 0), b3, voffB); PG8_STAGE(PG8_SB(1, 1), b3 + hstepB, voffB); PG8_STAGE(PG8_SA(1, 0), a3, vA0);
            PG8_WAIT_V(8); PG8_WAIT_L(0); PG8_BAR; PG8_MMA(1, 0, At, B0); PG8_MMA(1, 1, At, B1); PG8_BAR; PG8_SCHED;
        }
        if (wr == 0) PG8_BAR;
        E(acc, cur, ui, wr, wc, fr, fq);
        if (!has_next) break;
#pragma unroll
        for (int a = 0; a < 2; ++a)
#pragma unroll
            for (int b = 0; b < 2; ++b)
#pragma unroll
                for (int m = 0; m < 4; ++m)
#pragma unroll
                    for (int n = 0; n < 2; ++n) acc[a][b][m][n] = (f32x4){0.f, 0.f, 0.f, 0.f};
        cur = nxt; cA = nA; cB = nB; ++ui;
        if (wr == 1) PG8_BAR;
    }
    PG8_WAIT_V(0);
    PG8_BAR;
#undef PG8_SA
#undef PG8_SB
#undef PG8_STAGE
#undef PG8_LDA
#undef PG8_LDB
#undef PG8_MMA
#undef PG8_WAIT_V
#undef PG8_WAIT_L
#undef PG8_BAR
#undef PG8_SCHED
}
}

struct DenseSched {
    const char* A; const char* Bt; int K, nM, nN, nwg, G, c, latonly;
    __device__ __forceinline__ void init(const void* A_, const void* Bt_, int K_, int nM_, int nN_, int G_, int c_, int latonly_) { A = (const char*)A_; Bt = (const char*)Bt_; K = K_; nM = nM_; nN = nN_; nwg = nM * nN; G = G_; c = c_; latonly = latonly_; }
    __device__ __forceinline__ bool next(int i, pg8::Unit& u) const {
        const long L = (long)i * G + c; if (L >= nwg) return false;
        int wgid = (int)L; { const int q = nwg / 8, r = nwg % 8, xcd = wgid % 8, off = wgid / 8; wgid = (xcd < r ? xcd * (q + 1) : r * (q + 1) + (xcd - r) * q) + off; }
        const int nig = 8 * nN, gid = wgid / nig, fm = gid * 8, gsz = (nM - fm) < 8 ? (nM - fm) : 8;
        int pm = fm + ((wgid % nig) % gsz); u.pn = (wgid % nig) / gsz;
        if (latonly) pm = (pm >> 3) * 9 + (pm & 7);
        u.pm = pm; u.e = 0; u.nrow = 0; return true;
    }
    __device__ __forceinline__ const char* a_ptr(const pg8::Unit& u) const { return A + (size_t)u.pm * 256 * K * 2; }
    __device__ __forceinline__ const char* b_ptr(const pg8::Unit& u) const { return Bt + (size_t)u.pn * 256 * K * 2; }
    __device__ __forceinline__ void a_voff(const pg8::Unit&, int tid, int K_, unsigned (&v0)[2], unsigned (&v1)[2]) const {
#pragma unroll
        for (int i = 0; i < 2; ++i) { int R, C; pg8::stage_rc(tid * 16 + i * 8192, R, C); v0[i] = (unsigned)(R * K_ + C) * 2u; v1[i] = (unsigned)((128 + R) * K_ + C) * 2u; }
    }
};
__device__ __forceinline__ int moe_find(const LAS int* tab, int mt) { int e = 0;
#pragma unroll 1
    for (int j = 1; j < 32; ++j) e = (tab[32 + j] <= mt) ? j : e;
    return e; }
struct MoeGuSched {
    const char* HB; const char* W; const int* list; const LAS int* tab; int G, c;
    __device__ __forceinline__ bool next(int i, pg8::Unit& u) const {
        const int L = i * G + c, T = tab[64]; if (L >= 4 * T) return false;
        const int mt = L >> 2; u.pm = mt; u.pn = L & 3; const int e = moe_find(tab, mt); u.e = e; u.nrow = mt - tab[32 + e]; return true;
    }
    __device__ __forceinline__ const char* a_ptr(const pg8::Unit&) const { return HB; }
    __device__ __forceinline__ const char* b_ptr(const pg8::Unit& u) const { return W + ((size_t)u.e * 1024 + (size_t)u.pn * 256) * 1024 * 2; }
    __device__ __forceinline__ void a_voff(const pg8::Unit& u, int tid, int K_, unsigned (&v0)[2], unsigned (&v1)[2]) const {
        const int n = tab[u.e]; const int* lp = list + (size_t)u.e * MROWS;
#pragma unroll
        for (int i = 0; i < 2; ++i) { int R, C; pg8::stage_rc(tid * 16 + i * 8192, R, C);
            int i0 = u.nrow * 256 + R, i1 = i0 + 128; i0 = i0 < n ? i0 : n - 1; i1 = i1 < n ? i1 : n - 1;
            const int t0 = lp[i0], t1 = lp[i1];
            v0[i] = (unsigned)(t0 * K_ + C) * 2u; v1[i] = (unsigned)(t1 * K_ + C) * 2u; }
    }
};
struct MoeDownSched {
    const char* HID; const char* W; const LAS int* tab; int G, c;
    __device__ __forceinline__ bool next(int i, pg8::Unit& u) const {
        const int L = i * G + c, T = tab[64]; if (L >= 4 * T) return false;
        const int mt = L >> 2; u.pm = mt; u.pn = L & 3; u.e = moe_find(tab, mt); u.nrow = 0; return true;
    }
    __device__ __forceinline__ const char* a_ptr(const pg8::Unit& u) const { return HID + (size_t)u.pm * 256 * EFF * 2; }
    __device__ __forceinline__ const char* b_ptr(const pg8::Unit& u) const { return W + ((size_t)u.e * 1024 + (size_t)u.pn * 256) * EFF * 2; }
    __device__ __forceinline__ void a_voff(const pg8::Unit&, int tid, int K_, unsigned (&v0)[2], unsigned (&v1)[2]) const {
#pragma unroll
        for (int i = 0; i < 2; ++i) { int R, C; pg8::stage_rc(tid * 16 + i * 8192, R, C); v0[i] = (unsigned)(R * K_ + C) * 2u; v1[i] = (unsigned)((128 + R) * K_ + C) * 2u; }
    }
};

template <int KIND> struct EpiQKV {
    bf16_t* out; int ldo; const float* rope; const float* qg; const float* kg; LAS float* ss;
    __device__ __forceinline__ void operator()(f32x4 (&acc)[2][2][4][2], const pg8::Unit& u, int ui, int wr, int wc, int fr, int fq) const {
        const int pmod = u.pm % 9; const bool is_ctx = (pmod == 8); const int tb = pmod * 256;
        constexpr int nrope = (KIND == 2) ? 8 : 5;
        const bool isqk = u.pn < nrope, do_rope = isqk && !is_ctx;
        constexpr int NF = (KIND == 0) ? 32 : 16;
        const int axis = (KIND == 0) ? (wc >> 1) : (wc & 1), f0 = (KIND == 0) ? ((wc & 1) * 16 + 4 * fq) : 4 * fq;
        LAS float* S = ss + (ui & 1) * 2048;
        f32x4 g0 = (f32x4){1.f, 1.f, 1.f, 1.f}, g1 = g0;
        if constexpr (KIND == 0) {
#pragma unroll
            for (int ai = 0; ai < 2; ++ai)
#pragma unroll
                for (int m = 0; m < 4; ++m)
#pragma unroll
                    for (int bj = 0; bj < 2; ++bj) {
                        const f32x4 a = acc[ai][bj][m][0], b = acc[ai][bj][m][1];
                        float s = (a[0] * a[0] + a[1] * a[1]) + (a[2] * a[2] + a[3] * a[3]) + (b[0] * b[0] + b[1] * b[1]) + (b[2] * b[2] + b[3] * b[3]);
                        s = lane_xor_add<16>(s); s = lane_xor_add<32>(s);
                        if (fq == 0) S[(ai * 128 + wr * 64 + m * 16 + fr) * 8 + bj * 4 + wc] = s;
                    }
            asm volatile("s_waitcnt lgkmcnt(0)" ::: "memory"); __builtin_amdgcn_s_barrier(); asm volatile("" ::: "memory");
            if (isqk) { const float* gain = (u.pn < 4) ? qg : kg; g0 = *(const f32x4*)(gain + axis * 64 + f0); g1 = *(const f32x4*)(gain + axis * 64 + 32 + f0); }
        }
#pragma unroll
        for (int ai = 0; ai < 2; ++ai)
#pragma unroll
            for (int m = 0; m < 4; ++m) {
                const int rt = ai * 128 + wr * 64 + m * 16 + fr, t = tb + rt, pos = axis ? (t & 63) : (t >> 6);
                f32x4 cs = (f32x4){1.f, 1.f, 1.f, 1.f}, sn = (f32x4){0.f, 0.f, 0.f, 0.f};
                if (do_rope) { cs = *(const f32x4*)(rope + pos * NF + f0); sn = *(const f32x4*)(rope + 64 * NF + pos * NF + f0); }
                bf16_t* rowp = out + (size_t)(u.pm * 256 + rt) * ldo + u.pn * 256 + wc * 32 + 4 * fq;
#pragma unroll
                for (int bj = 0; bj < 2; ++bj) {
                    f32x4 x1 = acc[ai][bj][m][0], x2 = acc[ai][bj][m][1];
                    if constexpr (KIND == 0) { if (isqk) {
                        const f32x4 pp = *(const LAS f32x4*)(S + rt * 8 + bj * 4);
                        const float r = 1.0f / sqrtf(((pp[0] + pp[1]) + (pp[2] + pp[3])) * (1.0f / 128.0f) + RMS_EPS);
                        x1 = x1 * r * g0; x2 = x2 * r * g1; } }
                    const f32x4 o1 = x1 * cs - x2 * sn, o2 = x1 * sn + x2 * cs;
                    u32x2 w; w.x = cvt_pk_bf16(o1[0], o1[1]); w.y = cvt_pk_bf16(o1[2], o1[3]); *(u32x2*)(rowp + bj * 128) = w;
                    w.x = cvt_pk_bf16(o2[0], o2[1]); w.y = cvt_pk_bf16(o2[2], o2[3]); *(u32x2*)(rowp + bj * 128 + 16) = w;
                }
                asm volatile("" ::: "memory");
            }
    }
};
struct EpiWo {
    const float* X; float* Y; const float* mod;
    const float* xlat; const float* xctx;
    __device__ __forceinline__ void operator()(f32x4 (&acc)[2][2][4][2], const pg8::Unit& u, int, int wr, int wc, int fr, int fq) const {
        const int bb = (u.pm % 9 == 8) ? 8 : u.pm / 9; const float* g1 = mod + bb * 6144 + 2048;
        const float* Xt = X + (size_t)u.pm * 256 * DM;
        if (xlat) Xt = (u.pm % 9 == 8) ? xctx + (size_t)(u.pm / 9) * CTXL * DM : xlat + ((size_t)(u.pm / 9) * SEQ + (u.pm % 9) * 256) * DM;
        const int col0 = u.pn * 256 + wc * 32 + 4 * fq;
        f32x4 gv[2][2];
#pragma unroll
        for (int bj = 0; bj < 2; ++bj)
#pragma unroll
            for (int n = 0; n < 2; ++n) gv[bj][n] = *(const f32x4*)(g1 + col0 + bj * 128 + n * 16);
#pragma unroll
        for (int ai = 0; ai < 2; ++ai)
#pragma unroll
            for (int m = 0; m < 4; ++m) { const size_t offt = (size_t)(ai * 128 + wr * 64 + m * 16 + fr) * DM + col0, off = (size_t)u.pm * 256 * DM + offt;
#pragma unroll
                for (int bj = 0; bj < 2; ++bj)
#pragma unroll
                    for (int n = 0; n < 2; ++n) { const f32x4 xv = *(const f32x4*)(Xt + offt + bj * 128 + n * 16); *(f32x4*)(Y + off + bj * 128 + n * 16) = xv * ALPHA + gv[bj][n] * acc[ai][bj][m][n]; }
                if (m & 1) asm volatile("" ::: "memory"); }
    }
};
struct EpiGU {
    bf16_t* HID;
    __device__ __forceinline__ void operator()(f32x4 (&acc)[2][2][4][2], const pg8::Unit& u, int, int wr, int wc, int fr, int fq) const {
#pragma unroll
        for (int ai = 0; ai < 2; ++ai)
#pragma unroll
            for (int m = 0; m < 4; ++m) { bf16_t* rowp = HID + (size_t)(u.pm * 256 + ai * 128 + wr * 64 + m * 16 + fr) * EFF + u.pn * 128 + wc * 32 + 4 * fq;
#pragma unroll
                for (int n = 0; n < 2; ++n) { const f32x4 a = acc[ai][0][m][n], b = acc[ai][1][m][n]; f32x4 h;
#pragma unroll
                    for (int j = 0; j < 4; ++j) h[j] = a[j] * __builtin_amdgcn_rcpf(1.0f + __expf(-a[j])) * b[j];
                    u32x2 w; w.x = cvt_pk_bf16(h[0], h[1]); w.y = cvt_pk_bf16(h[2], h[3]); *(u32x2*)(rowp + n * 16) = w; } }
    }
};
struct EpiDown {
    bf16_t* YS;
    __device__ __forceinline__ void operator()(f32x4 (&acc)[2][2][4][2], const pg8::Unit& u, int, int wr, int wc, int fr, int fq) const {
#pragma unroll
        for (int ai = 0; ai < 2; ++ai)
#pragma unroll
            for (int m = 0; m < 4; ++m) { bf16_t* rowp = YS + (size_t)(u.pm * 256 + ai * 128 + wr * 64 + m * 16 + fr) * DM + u.pn * 256 + wc * 32 + 4 * fq;
#pragma unroll
                for (int bj = 0; bj < 2; ++bj)
#pragma unroll
                    for (int n = 0; n < 2; ++n) { const f32x4 v = acc[ai][bj][m][n]; u32x2 w; w.x = cvt_pk_bf16(v[0], v[1]); w.y = cvt_pk_bf16(v[2], v[3]); *(u32x2*)(rowp + bj * 128 + n * 16) = w; } }
    }
};

namespace att {
#define SBAR() __builtin_amdgcn_sched_barrier(0)
__device__ __forceinline__ int crow(int r, int hi) { return (r & 3) + 8 * (r >> 2) + 4 * hi; }
template <int DQK> __device__ __forceinline__ int kswz(int row, int colB) { return row * (DQK * 2) + (colB ^ ((row & 7) << 4)); }
template <int NCB> __device__ __forceinline__ int v_st(int k, int c) { const int kk = (k & ~0xC) | ((k & 4) << 1) | ((k & 8) >> 1); return ((kk >> 3) * NCB + (c >> 5)) * 512 + ((kk & 7) * 32 + (c & 31)) * 2; }
__device__ __forceinline__ int v_rd_base(int lane) { return ((lane & 3) << 3) | (((lane >> 2) & 3) << 6) | (((lane >> 4) & 1) << 5) | (((lane >> 5) & 1) << 8); }
template <int NCB> constexpr int v_rd_off(int d0, int ks, int half) { return d0 * 512 + ks * (2 * NCB * 512) + half * (NCB * 512); }
template <int OFF> __device__ __forceinline__ s16x4 tr_read(int vb) { s16x4 r; asm volatile("ds_read_b64_tr_b16 %0, %1 offset:%2" : "=&v"(r) : "v"(vb), "i"(OFF) : "memory"); return r; }

template <int DQK> __device__ __forceinline__ void partialSM(f32x16& p0, f32x16& p1, float& m_reg, float& mn, float& alpha) {
    constexpr float SCALE = (DQK == 128) ? 0.088388347648318440f : 0.125f, C = SCALE * 1.4426950408889634f, THRS = 8.f / SCALE;
    float pmax = p0[0];
#pragma unroll
    for (int r = 1; r < 16; ++r) pmax = fmaxf(pmax, p0[r]);
#pragma unroll
    for (int r = 0; r < 16; ++r) pmax = fmaxf(pmax, p1[r]);
    { auto rr = __builtin_amdgcn_permlane32_swap(__float_as_uint(pmax), __float_as_uint(pmax), false, false); pmax = fmaxf(__uint_as_float(rr[0]), __uint_as_float(rr[1])); }
    if (__builtin_expect(__all(pmax - m_reg <= THRS), 1)) { mn = m_reg; alpha = 1.f; }
    else { mn = fmaxf(m_reg, pmax); alpha = __builtin_amdgcn_exp2f((m_reg - mn) * C); m_reg = mn; }
    const float mnC = -mn * C;
#pragma unroll
    for (int r = 0; r < 16; ++r) p0[r] = fmaf(p0[r], C, mnC);
#pragma unroll
    for (int r = 0; r < 16; ++r) p1[r] = fmaf(p1[r], C, mnC);
#pragma unroll
    for (int r = 0; r < 16; ++r) p0[r] = __builtin_amdgcn_exp2f(p0[r]);
}
__device__ __forceinline__ void finishSM(f32x16& p0, f32x16& p1, float alpha, float& l_reg, bf16x8& pa0, bf16x8& pa1, bf16x8& pa2, bf16x8& pa3) {
#pragma unroll
    for (int r = 0; r < 16; ++r) p1[r] = __builtin_amdgcn_exp2f(p1[r]);
    float ps = 0;
#pragma unroll
    for (int r = 0; r < 16; ++r) ps += p0[r];
#pragma unroll
    for (int r = 0; r < 16; ++r) ps += p1[r];
    { auto rr = __builtin_amdgcn_permlane32_swap(__float_as_uint(ps), __float_as_uint(ps), false, false); ps = __uint_as_float(rr[0]) + __uint_as_float(rr[1]); }
    l_reg = l_reg * alpha + ps;
#define PK4(P, BASE, OUT) do { unsigned a0 = cvt_pk_bf16(P[BASE + 0], P[BASE + 1]), a1 = cvt_pk_bf16(P[BASE + 2], P[BASE + 3]);   \
    unsigned b0 = cvt_pk_bf16(P[BASE + 4], P[BASE + 5]), b1 = cvt_pk_bf16(P[BASE + 6], P[BASE + 7]);                              \
    auto r0 = __builtin_amdgcn_permlane32_swap(a0, b0, false, false); auto r1 = __builtin_amdgcn_permlane32_swap(a1, b1, false, false); \
    u32x4 w = {r0[0], r1[0], r0[1], r1[1]}; OUT = __builtin_bit_cast(bf16x8, w); } while (0)
    PK4(p0, 0, pa0); PK4(p0, 8, pa1); PK4(p1, 0, pa2); PK4(p1, 8, pa3);
#undef PK4
}
template <int DQK> __device__ __forceinline__ void qkt(f32x16& p0, f32x16& p1, const LAS char* Ks, const bf16x8* qr, int r32, int hi) {
    p0 = f32x16{}; p1 = f32x16{};
#pragma unroll
    for (int d0 = 0; d0 < DQK / 16; ++d0) { const int cb = (d0 * 16 + hi * 8) * 2;
        const bf16x8 b0 = *(const LAS bf16x8*)(Ks + kswz<DQK>(r32, cb));
        const bf16x8 b1 = *(const LAS bf16x8*)(Ks + kswz<DQK>(32 + r32, cb));
        p0 = __builtin_amdgcn_mfma_f32_32x32x16_bf16(b0, qr[d0], p0, 0, 0, 0);
        p1 = __builtin_amdgcn_mfma_f32_32x32x16_bf16(b1, qr[d0], p1, 0, 0, 0); }
}
template <int NCB, int D0> __device__ __forceinline__ void pv_one(f32x16& od, int vb, bf16x8 pa0, bf16x8 pa1, bf16x8 pa2, bf16x8 pa3) {
    const s16x4 l0 = tr_read<v_rd_off<NCB>(D0, 0, 0)>(vb), h0 = tr_read<v_rd_off<NCB>(D0, 0, 1)>(vb), l1 = tr_read<v_rd_off<NCB>(D0, 1, 0)>(vb), h1 = tr_read<v_rd_off<NCB>(D0, 1, 1)>(vb);
    const s16x4 l2 = tr_read<v_rd_off<NCB>(D0, 2, 0)>(vb), h2 = tr_read<v_rd_off<NCB>(D0, 2, 1)>(vb), l3 = tr_read<v_rd_off<NCB>(D0, 3, 0)>(vb), h3 = tr_read<v_rd_off<NCB>(D0, 3, 1)>(vb);
    asm volatile("s_waitcnt lgkmcnt(0)" ::: "memory"); SBAR();
#define PK(L, H) (bf16x8){L[0], L[1], L[2], L[3], H[0], H[1], H[2], H[3]}
    od = __builtin_amdgcn_mfma_f32_32x32x16_bf16(pa0, PK(l0, h0), od, 0, 0, 0);
    od = __builtin_amdgcn_mfma_f32_32x32x16_bf16(pa1, PK(l1, h1), od, 0, 0, 0);
    od = __builtin_amdgcn_mfma_f32_32x32x16_bf16(pa2, PK(l2, h2), od, 0, 0, 0);
    od = __builtin_amdgcn_mfma_f32_32x32x16_bf16(pa3, PK(l3, h3), od, 0, 0, 0);
#undef PK
}
template <int DV> __device__ __forceinline__ void pv_all(f32x16 (&o)[DV / 32], int vb, bf16x8 pa0, bf16x8 pa1, bf16x8 pa2, bf16x8 pa3) {
    constexpr int NCB = DV / 32;
    pv_one<NCB, 0>(o[0], vb, pa0, pa1, pa2, pa3); pv_one<NCB, 1>(o[1], vb, pa0, pa1, pa2, pa3);
    if constexpr (DV == 128) { pv_one<NCB, 2>(o[2], vb, pa0, pa1, pa2, pa3); pv_one<NCB, 3>(o[3], vb, pa0, pa1, pa2, pa3); }
}

template <int DQK, int DV, bool WIN>
__device__ __forceinline__ void attn_core(const bf16_t* __restrict__ Qb, const int ldq, const bf16_t* __restrict__ Kh, const bf16_t* __restrict__ Vh, const int ldk,
                                          const int NT, const int nfirst, const int base1, const int base2, const int qpos0,
                                          LAS char* lds, f32x16 (&o)[DV / 32], float& m_out, float& l_out) {
    constexpr int SHM_V = 64 * DV * 2, SHM_K = 64 * DQK * 2, KP = DQK / 64, VP = DV / 64, NCB = DV / 32, ND = DQK / 16;
    int tid = threadIdx.x; asm volatile("" : "+v"(tid));
    const int wid = tid >> 6, lane = tid & 63, r32 = lane & 31, hi = lane >> 5;
    LAS char* V_lds = lds; LAS char* K_lds = lds + 2 * SHM_V;
    LAS float* ws = (LAS float*)(lds + 2 * SHM_V + 2 * SHM_K) + wid * 64; LAS float* al_l = ws + 32;
    float m_reg = -1e30f, l_reg = 0.f;
#pragma unroll
    for (int d = 0; d < DV / 32; ++d) o[d] = f32x16{};
    bf16x8 qr[ND];
    const bf16_t* Qw = Qb + (size_t)(wid * 32 + r32) * ldq + hi * 8;
#pragma unroll
    for (int d0 = 0; d0 < ND; ++d0) qr[d0] = *(const bf16x8*)(Qw + d0 * 16);
    const int ksr = (KP == 2) ? (tid >> 4) : (tid >> 3), ksc = (KP == 2) ? (tid & 15) * 8 : (tid & 7) * 8;
    const int vsr = (VP == 2) ? (tid >> 4) : (tid >> 3), vsc = (VP == 2) ? (tid & 15) * 8 : (tid & 7) * 8;
    const int kst0 = kswz<DQK>(ksr, ksc * 2), kst1 = kswz<DQK>(32 + ksr, ksc * 2), vst0 = v_st<NCB>(vsr, vsc), vst1 = v_st<NCB>(32 + vsr, vsc);
    const int vb0 = (int)(unsigned)(uintptr_t)V_lds + v_rd_base(lane);
    struct { bf16x8 vs0, vs1, ks0, ks1; } sr_[2];
#define KB(j) (((j) < nfirst) ? base1 + 64 * (j) : base2 + 64 * ((j) - nfirst))
#define SLOAD(i, j) do { const int kb_ = KB(j); sr_[i].ks0 = *(const bf16x8*)(&Kh[(size_t)(kb_ + ksr) * ldk + ksc]); if (KP == 2) sr_[i].ks1 = *(const bf16x8*)(&Kh[(size_t)(kb_ + 32 + ksr) * ldk + ksc]); \
    sr_[i].vs0 = *(const bf16x8*)(&Vh[(size_t)(kb_ + vsr) * ldk + vsc]); if (VP == 2) sr_[i].vs1 = *(const bf16x8*)(&Vh[(size_t)(kb_ + 32 + vsr) * ldk + vsc]); } while (0)
#define SWRITE(b, i) do { *(LAS bf16x8*)(V_lds + (b) * SHM_V + vst0) = sr_[i].vs0; if (VP == 2) *(LAS bf16x8*)(V_lds + (b) * SHM_V + vst1) = sr_[i].vs1; \
    *(LAS bf16x8*)(K_lds + (b) * SHM_K + kst0) = sr_[i].ks0; if (KP == 2) *(LAS bf16x8*)(K_lds + (b) * SHM_K + kst1) = sr_[i].ks1; } while (0)
#define RESC(a) do { if (__any((a) < 1.f)) { if (hi == 0) al_l[r32] = (a); asm volatile("s_waitcnt lgkmcnt(0)" ::: "memory"); \
    _Pragma("unroll") for (int d = 0; d < DV / 32; ++d) _Pragma("unroll") for (int r = 0; r < 16; ++r) o[d][r] *= al_l[crow(r, hi)]; } } while (0)
#define MASK(P0, P1, j) do { if (WIN && (j) >= nfirst) { const int dq_ = base2 + 64 * ((j) - nfirst) - (qpos0 + wid * 32 + r32); \
    _Pragma("unroll") for (int r = 0; r < 16; ++r) { const int dd_ = dq_ + crow(r, hi); if ((unsigned)(dd_ + 128) > 256u) P0[r] = -1e30f; if ((unsigned)(dd_ + 160) > 256u) P1[r] = -1e30f; } } } while (0)
    f32x16 pA0, pA1, pB0, pB1; float mnA, mnB, alA, alB; bf16x8 pa0, pa1, pa2, pa3;
    const int qw_ = qpos0 + __builtin_amdgcn_readfirstlane(wid) * 32;
#define NEED(j) (!WIN || (j) < nfirst || ((base2 + 64 * ((j) - nfirst) + 63 >= qw_ - 128) && (base2 + 64 * ((j) - nfirst) <= qw_ + 159)))
#define QKT(P0, P1, KL, j) do { if (NEED(j)) { qkt<DQK>(P0, P1, KL, qr, r32, hi); MASK(P0, P1, j); } else { _Pragma("unroll") for (int r = 0; r < 16; ++r) { P0[r] = -1e30f; P1[r] = -1e30f; } } } while (0)
#define PV(VB, j) do { if (NEED(j)) pv_all<DV>(o, VB, pa0, pa1, pa2, pa3); } while (0)
    SLOAD(0, 0); asm volatile("s_waitcnt vmcnt(0)" ::: "memory"); SWRITE(0, 0); __syncthreads();
    QKT(pA0, pA1, K_lds, 0); partialSM<DQK>(pA0, pA1, m_reg, mnA, alA);
    SLOAD(1, 1); if (2 < NT) SLOAD(0, 2);
    SWRITE(1, 1); __syncthreads();
    for (int j = 1; j + 1 < NT; j += 2) {
        SBAR(); QKT(pB0, pB1, K_lds + SHM_K, j);
        finishSM(pA0, pA1, alA, l_reg, pa0, pa1, pa2, pa3); SBAR();
        SLOAD(1, j + 2); SBAR();
        PV(vb0, j - 1); partialSM<DQK>(pB0, pB1, m_reg, mnB, alB);
        __syncthreads(); SWRITE(0, 0);
        RESC(alB); __syncthreads();
        SBAR(); QKT(pA0, pA1, K_lds, j + 1);
        finishSM(pB0, pB1, alB, l_reg, pa0, pa1, pa2, pa3); SBAR();
        if (j + 3 < NT) SLOAD(0, j + 3); SBAR();
        PV(vb0 + SHM_V, j); partialSM<DQK>(pA0, pA1, m_reg, mnA, alA);
        __syncthreads(); SWRITE(1, 1);
        RESC(alA); __syncthreads();
    }
    SBAR(); QKT(pB0, pB1, K_lds + SHM_K, NT - 1);
    finishSM(pA0, pA1, alA, l_reg, pa0, pa1, pa2, pa3); SBAR();
    PV(vb0, NT - 2); partialSM<DQK>(pB0, pB1, m_reg, mnB, alB);
    __syncthreads(); RESC(alB);
    finishSM(pB0, pB1, alB, l_reg, pa0, pa1, pa2, pa3); SBAR();
    PV(vb0 + SHM_V, NT - 1);
    m_out = m_reg; l_out = l_reg;
#undef KB
#undef SLOAD
#undef SWRITE
#undef RESC
#undef MASK
#undef NEED
#undef QKT
#undef PV
}
__device__ __forceinline__ void row_bcast(LAS float* ws, float v, int r32, int hi, float (&out)[16]) {
    if (hi == 0) ws[r32] = v; asm volatile("s_waitcnt lgkmcnt(0)" ::: "memory");
#pragma unroll
    for (int r = 0; r < 16; ++r) out[r] = ws[crow(r, hi)];
    asm volatile("s_waitcnt lgkmcnt(0)" ::: "memory");
}
#undef SBAR
}

constexpr int NPHASE = 3 + 7 * DEPTH;
struct Args { const float* in[29]; float* out; unsigned char* ws; int ph_lo, ph_hi; };

__device__ __forceinline__ void sincos_small(double x, double& s, double& c) {
    const double k = __builtin_rint(x * 0.6366197723675814);
    const double r = (x - k * 1.5707963267341256) - k * 6.077100506506192e-11;
    const double r2 = r * r;
    double sp = 1.0 / 6402373705728000.0, cp = 1.0 / 355687428096000.0;
    double cs = -sp; cs = cs * r2 + 1.0 / 20922789888000.0; cs = cs * r2 - 1.0 / 87178291200.0; cs = cs * r2 + 1.0 / 479001600.0; cs = cs * r2 - 1.0 / 3628800.0;
    cs = cs * r2 + 1.0 / 40320.0; cs = cs * r2 - 1.0 / 720.0; cs = cs * r2 + 1.0 / 24.0; cs = cs * r2 - 0.5; cs = cs * r2 + 1.0;
    double sn = cp; sn = sn * r2 - 1.0 / 1307674368000.0; sn = sn * r2 + 1.0 / 6227020800.0; sn = sn * r2 - 1.0 / 39916800.0; sn = sn * r2 + 1.0 / 362880.0;
    sn = sn * r2 - 1.0 / 5040.0; sn = sn * r2 + 1.0 / 120.0; sn = sn * r2 - 1.0 / 6.0; sn = sn * r2 + 1.0; sn = sn * r;
    const int q = ((int)k) & 3;
    s = (q == 0) ? sn : (q == 1) ? cs : (q == 2) ? -sn : -cs;
    c = (q == 0) ? cs : (q == 1) ? -sn : (q == 2) ? -cs : sn;
}

__device__ __forceinline__ void tile_load(f32x4 (&v)[16], const float* __restrict__ src, int N, int k0, int n0, int lane) {
    const int rsub = lane >> 4, c4 = (lane & 15) * 4;
#pragma unroll
    for (int i = 0; i < 16; ++i) v[i] = __builtin_nontemporal_load((const f32x4*)(src + (size_t)(k0 + 4 * i + rsub) * N + n0 + c4));
}
__device__ __forceinline__ void tile_store(const f32x4 (&v)[16], int k0, bf16_t* __restrict__ dst, int ldk, int drow0, bool perm, LAS float* scr, int lane) {
    const int rsub = lane >> 4, c4 = (lane & 15) * 4;
#pragma unroll
    for (int i = 0; i < 16; ++i) { LAS float* p = scr + (4 * i + rsub) * 65 + c4; p[0] = v[i][0]; p[1] = v[i][1]; p[2] = v[i][2]; p[3] = v[i][3]; }
    asm volatile("s_waitcnt lgkmcnt(0)" ::: "memory");
    const int c = lane & 7, nl = lane >> 3;
#pragma unroll
    for (int j = 0; j < 8; ++j) { const int n = nl + 8 * j; const LAS float* s = scr + (8 * c) * 65 + n;
        u32x4 o; o.x = cvt_pk_bf16(s[0], s[65]); o.y = cvt_pk_bf16(s[2 * 65], s[3 * 65]); o.z = cvt_pk_bf16(s[4 * 65], s[5 * 65]); o.w = cvt_pk_bf16(s[6 * 65], s[7 * 65]);
        const int nn = perm ? ((n & 15) | ((n & 16) << 1) | ((n & 32) >> 1)) : n;
        *(u32x4*)(dst + (size_t)(drow0 + nn) * ldk + k0 + 8 * c) = o; }
    asm volatile("s_waitcnt lgkmcnt(0)" ::: "memory");
}
__device__ __forceinline__ void transpose_tile(const float* __restrict__ src, int N, int k0, int n0, bf16_t* __restrict__ dst, int ldk, int drow0, bool perm, LAS float* scr, int lane) {
    f32x4 v[16]; tile_load(v, src, N, k0, n0, lane); tile_store(v, k0, dst, ldk, drow0, perm, scr, lane);
}

constexpr int CW_Q = 24576;
__device__ __forceinline__ void drain_moe_tiles(int l, int npull, unsigned* ctl, const float* wgate, const float* wup, const float* wdown, bf16_t* WGU, bf16_t* WD, LAS float* scr, LAS unsigned* bc, int wave, int tid, int lane) {
    for (int n = 0; npull < 0 || n < npull; ++n) {
        if (tid == 0) { unsigned h = __hip_atomic_load(ctl + CW_Q + l * 64, RLX_AGENT); if (h < 12288u) h = atomicAdd(ctl + CW_Q + l * 64, 32u); bc[0] = h; }
        __syncthreads();
        const unsigned idw = bc[0];
        __syncthreads();
        if (idw >= 12288u) break;
        const unsigned id0 = idw + 4u * (unsigned)wave;
#define MOE_TILE(ID, SRC, NN, K0, N0, DST, LDK, DROW) do { const int id_ = (ID), which_ = id_ >> 12, r_ = id_ & 4095, lge_ = l * 32 + (r_ >> 7), rr_ = r_ & 127; \
        if (which_ < 2) { K0 = (rr_ >> 3) * 64; N0 = (rr_ & 7) * 64; NN = 512; SRC = (which_ ? wup : wgate) + (size_t)lge_ * 1024 * 512; DST = WGU; LDK = 1024; DROW = lge_ * 1024 + (N0 >> 7) * 256 + which_ * 128 + (N0 & 127); } \
        else { K0 = (rr_ >> 4) * 64; N0 = (rr_ & 15) * 64; NN = 1024; SRC = wdown + (size_t)lge_ * 512 * 1024; DST = WD; LDK = 512; DROW = lge_ * 1024 + N0; } } while (0)
        f32x4 va[16], vb[16]; const float* sa; const float* sb; bf16_t* da; bf16_t* db; int na, nb, ka, kb, n0a, n0b, la, lb, ra, rb;
        MOE_TILE((int)id0 + 0, sa, na, ka, n0a, da, la, ra); tile_load(va, sa, na, ka, n0a, lane);
        MOE_TILE((int)id0 + 1, sb, nb, kb, n0b, db, lb, rb); tile_load(vb, sb, nb, kb, n0b, lane);
        tile_store(va, ka, da, la, ra, false, scr, lane);
        MOE_TILE((int)id0 + 2, sa, na, ka, n0a, da, la, ra); tile_load(va, sa, na, ka, n0a, lane);
        tile_store(vb, kb, db, lb, rb, false, scr, lane);
        MOE_TILE((int)id0 + 3, sb, nb, kb, n0b, db, lb, rb); tile_load(vb, sb, nb, kb, n0b, lane);
        tile_store(va, ka, da, la, ra, false, scr, lane);
        tile_store(vb, kb, db, lb, rb, false, scr, lane);
#undef MOE_TILE
    }
}

__global__ void __launch_bounds__(512, 2) fwd(Args args) {
    extern __shared__ __attribute__((aligned(16))) unsigned char lds_raw[];
    LAS unsigned char* lds = (LAS unsigned char*)lds_raw;
    volatile LAS unsigned* MISC = (volatile LAS unsigned*)(lds + MISC_OFF);
    LAS unsigned char* ring = lds + RING_OFF;
    LAS int* tab = (LAS int*)(lds + TAB_OFF);
    const int wave = __builtin_amdgcn_readfirstlane((int)threadIdx.x >> 6);
#define PHASE_TID() int tid = threadIdx.x; asm volatile("" : "+v"(tid)); const int lane = tid & 63; (void)lane
    const int G = gridDim.x, bx = blockIdx.x;
    const int vcu = (G % 8 == 0) ? (bx % 8) * (G / 8) + bx / 8 : bx;
    const int gw = bx * 8 + wave, NGW = G * 8, NGT = G * 512;
    unsigned char* ws = args.ws;
    unsigned* ctl = (unsigned*)(ws + WS_CTL);
#define WSP(T, off) ((T*)(opaque(ws) + (off)))
#define DRAIN(L, NPULL) do { PHASE_TID(); drain_moe_tiles((L), (NPULL), (unsigned*)opaque(ws), args.in[26], args.in[27], args.in[28], WSP(bf16_t, WS_WGU), WSP(bf16_t, WS_WD), (LAS float*)ring + wave * (64 * 65), (LAS unsigned*)(lds + RI_OFF), wave, tid, lane); } while (0)
    constexpr int PULLS_PER_UNIT = 1;
    if (threadIdx.x < 128) ((LAS unsigned*)(lds + MISC_OFF))[threadIdx.x] = 0u;
    __syncthreads();
    XcdBarrier bar; bar.bar = ctl + CW_BAR; bar.x = 0; bar.st = nullptr;
    if (MK_N_LAUNCHES == 1) bar = xcd_barrier_post(ctl + CW_BAR, MISC + 8);
    const int lo = args.ph_lo, hi = args.ph_hi;
#ifndef PHMASK
#define PHMASK 0x3ff
#endif
#define EN(bit) ((PHMASK >> (bit)) & 1)
#ifndef DUPMASK
#define DUPMASK 0
#endif
#define REP(k) _Pragma("unroll 1") for (int rep_ = 0; rep_ < (((DUPMASK >> (k)) & 1) ? 2 : 1); ++rep_)
#define IN(k) (lo <= (k) && (k) < hi)
#ifndef PSEL
#define PSEL 0
#endif
    constexpr int CW_PROBE = 32768, PMUL = 8; unsigned long long t_prev = 0; unsigned long long pacc = 0;
    if (PSEL) t_prev = __builtin_amdgcn_s_memrealtime();
#define SEAM(k) do { if (MK_N_LAUNCHES == 1) { if ((k) + 1 < hi) { \
        unsigned long long t0_ = 0; if (PSEL) t0_ = __builtin_amdgcn_s_memrealtime(); \
        xcd_barrier(bar); if ((DUPMASK >> 11) & 1) xcd_barrier(bar); \
        if (PSEL) { const unsigned long long t1_ = __builtin_amdgcn_s_memrealtime(); const unsigned w_ = (unsigned)(t1_ - t0_); \
            if (threadIdx.x == 0) { atomicMax(ctl + CW_PROBE + (k), 0x40000000u - w_); atomicAdd(ctl + CW_PROBE + 64 + (k), w_); } \
            const int ty_ = ((k) < 3) ? (k) : 3 + ((k) - 3) % 7 + (((k) - 3) % 7 == 1 ? 0 : 0); \
            if (PSEL >= 10 && PSEL < 30 && ty_ == PSEL - 10) pacc += (t1_ - t_prev); \
            if (PSEL >= 30 && (k) == PSEL - 30) pacc += (t1_ - t_prev); \
            t_prev = t1_; } } } } while (0)

    if (EN(0) && IN(0)) { REP(0) {
        PHASE_TID(); const int gt = bx * 512 + tid;
        const float* cvec = args.in[1]; const float* cctx = args.in[3]; const float* w_mod = args.in[4];
        float* PART = WSP(float, WS_PART); bf16_t* WQKV = WSP(bf16_t, WS_WQKV); bf16_t* WO = WSP(bf16_t, WS_WO);
        float* ROPE128 = WSP(float, WS_ROPE); float* ROPE64 = WSP(float, WS_ROPE + 16384); float* WR = WSP(float, WS_WR);
        LAS float* SL = (LAS float*)ring;
        for (int i = tid; i < 9 * 1024; i += 512) { const int bb = i >> 10, k = i & 1023; const float c = bb < 8 ? cvec[bb * 1024 + k] : cctx[k]; SL[i] = c / (1.0f + expf(-c)); }
        __syncthreads();
        for (int it = gw; it < 4 * 24 * KSPLIT; it += NGW) {
            const int ks = it % KSPLIT, cb = (it / KSPLIT) % 24, l = it / (KSPLIT * 24);
            f32x4 acc[9];
#pragma unroll
            for (int bb = 0; bb < 9; ++bb) acc[bb] = (f32x4){0.f, 0.f, 0.f, 0.f};
            const float* w = w_mod + ((size_t)l * 1024 + ks * 64) * 6144 + cb * 256 + 4 * lane;
#pragma unroll 8
            for (int kk = 0; kk < 64; ++kk) { const f32x4 wv = *(const f32x4*)(w + (size_t)kk * 6144);
#pragma unroll
                for (int bb = 0; bb < 9; ++bb) acc[bb] += SL[bb * 1024 + ks * 64 + kk] * wv; }
#pragma unroll
            for (int bb = 0; bb < 9; ++bb) *(f32x4*)(PART + (((size_t)ks * 4 + l) * 9 + bb) * 6144 + cb * 256 + 4 * lane) = acc[bb];
        }
        __syncthreads();
        LAS float* scr = (LAS float*)ring + wave * (64 * 65);
        constexpr int T_QKV = 1920, T_WO = 1024, T_ALL = T_QKV + T_WO;
        for (int id0 = gw; id0 < T_ALL; id0 += NGW) {
            int id = id0;
            if (id < T_QKV) {
                int l, r; if (id < 384) { l = 0; r = id; } else if (id < 768) { l = 1; r = id - 384; } else if (id < 1536) { l = 2; r = id - 768; } else { l = 3; r = id - 1536; }
                const int N = (l == 2) ? 3072 : 1536, nbN = N / 64, kb = r / nbN, nb = r % nbN;
                const float* src = (l == 0) ? args.in[8] : (l == 1) ? args.in[12] : (l == 2) ? args.in[15] : args.in[8] + (size_t)1024 * 1536;
                const int drow = (l == 0) ? 0 : (l == 1) ? 1536 : (l == 2) ? 3072 : 6144;
                const bool perm = (l == 0 || l == 3) && (nb * 64 < 1280);
                transpose_tile(src, N, kb * 64, nb * 64, WQKV, 1024, drow + nb * 64, perm, scr, lane);
            } else { id -= T_QKV;
                const int l = id >> 8, r = id & 255, kb = r >> 4, nb = r & 15;
                const float* src = (l == 0) ? args.in[11] : (l == 1) ? args.in[14] : (l == 2) ? args.in[21] : args.in[11] + (size_t)1024 * 1024;
                transpose_tile(src, 1024, kb * 64, nb * 64, WO + (size_t)l * 1024 * 1024, 1024, nb * 64, false, scr, lane);
            }
        }
        for (int i = gt; i < 64 * 32 + 64 * 16; i += NGT) {
            const bool big = i < 2048; const int ii = big ? i : i - 2048, NF = big ? 32 : 16, pos = ii / NF, f = ii % NF;
            const double base = big ? 0.7498942093324559 : 0.5623413251903491; double inv = 1.0;
            for (int q = 0; q < f; ++q) inv *= base;
            const float ang = (float)pos * (float)inv; double s, c; sincos_small((double)ang, s, c);
            float* Tt = big ? ROPE128 : ROPE64; Tt[ii] = (float)c; Tt[64 * NF + ii] = (float)s;
        }
        { const float* wg = args.in[22]; const float* we = args.in[24];
          for (int i = gt; i < 4 * 36 * 1024; i += NGT) { const int l = i / (36 * 1024), e = (i >> 10) % 36, c = i & 1023;
              WR[i] = (e < 4) ? wg[((size_t)l * 1024 + c) * 4 + e] : we[((size_t)l * 1024 + c) * 32 + (e - 4)]; } }
        __syncthreads(); }
        SEAM(0);
    }
    if (EN(1) && IN(2)) { REP(1) {
        PHASE_TID(); const int gt = bx * 512 + tid;
        const float* xin = args.in[0]; const float* cin = args.in[2]; const float* b_mod = args.in[5]; float* PART = WSP(float, WS_PART); float* MOD = WSP(float, WS_MOD); bf16_t* HB = WSP(bf16_t, WS_HB);
        for (int i = gt; i < 4 * 9 * 6144; i += NGT) { const int l = i / 55296, bbj = i % 55296, j = bbj % 6144; float s = b_mod[l * 6144 + j];
#pragma unroll
            for (int ks = 0; ks < KSPLIT; ++ks) s += PART[((size_t)ks * 4 + l) * 55296 + bbj];
            MOD[i] = s; }
        const int RPW = MROWS / NGW, bwg = (bx * 8 * RPW) / TPB;
        LAS float* MV = (LAS float*)ring;
        __syncthreads();
        for (int i = tid; i < 4096; i += 512) { const int which = i >> 10, c = i & 1023, bb = (which < 2) ? bwg : 8, j = (which & 1) * 1024 + c; float s = b_mod[j];
#pragma unroll
            for (int ks = 0; ks < KSPLIT; ++ks) s += PART[((size_t)ks * 4) * 55296 + (size_t)bb * 6144 + j];
            MV[i] = s; }
        __syncthreads();
        for (int r0 = gw * RPW; r0 < (gw + 1) * RPW; r0 += 3) {
            f32x4 v[3][4]; int rr[3];
#pragma unroll
            for (int k = 0; k < 3; ++k) { rr[k] = (r0 + k < (gw + 1) * RPW) ? r0 + k : r0; const int b = rr[k] / TPB, t = rr[k] % TPB;
                const float* src = (t >= SEQ) ? cin + ((size_t)b * CTXL + (t - SEQ)) * DM : xin + ((size_t)b * SEQ + t) * DM;
#pragma unroll
                for (int j = 0; j < 4; ++j) v[k][j] = *(const f32x4*)(src + 4 * lane + 256 * j); }
#pragma unroll
            for (int k = 0; k < 3; ++k) { const int o = ((rr[k] % TPB) >= SEQ) ? 2048 : 0;
#pragma unroll
                for (int j = 0; j < 4; ++j) { const int c = 4 * lane + 256 * j;
                    const f32x4 h = v[k][j] * (*(const LAS f32x4*)(MV + o + 1024 + c) + 1.0f) + *(const LAS f32x4*)(MV + o + c);
                    u32x2 w; w.x = cvt_pk_bf16(h[0], h[1]); w.y = cvt_pk_bf16(h[2], h[3]); *(u32x2*)(HB + (size_t)rr[k] * DM + c) = w; } }
        } }
        SEAM(2);
    }
#pragma unroll 1
    for (int l = 0; l < DEPTH; ++l) {
        const int kind = l % 3, P = 3 + 7 * l; const bool lastl = (l == DEPTH - 1);
#define MODL (WSP(float, WS_MOD) + (size_t)l * 9 * 6144)
        const int wq_row = (l == 0) ? 0 : (l == 1) ? 1536 : (l == 2) ? 3072 : 6144;
        const int NQ = (kind == 2) ? 3072 : 1536;
#define CNTL ((unsigned*)opaque(ws) + CW_CNT + l * 2048)
        if (EN(2) && IN(P + 0)) { REP(2) {
            DenseSched S; S.init(WSP(bf16_t, WS_HB), WSP(bf16_t, WS_WQKV) + (size_t)wq_row * 1024, 1024, 72, NQ / 256, G, bx, 0); bf16_t* qkv_o = WSP(bf16_t, WS_QKV);
            if (EN(7) && kind == 0) { EpiQKV<0> E{qkv_o, NQ, WSP(float, WS_ROPE), args.in[9] + (l / 3) * 128, args.in[10] + (l / 3) * 128, (LAS float*)(lds + SS_OFF)}; pg8::gemm_phase(ring, 1024, S, E); }
            else if (EN(8) && kind == 1) { EpiQKV<1> E{qkv_o, NQ, WSP(float, WS_ROPE + 16384), nullptr, nullptr, nullptr}; pg8::gemm_phase(ring, 1024, S, E); }
            else if (EN(9) && kind == 2) { EpiQKV<2> E{qkv_o, NQ, WSP(float, WS_ROPE + 16384), nullptr, nullptr, nullptr}; pg8::gemm_phase(ring, 1024, S, E); }
            { const int nwg = 72 * (NQ / 256), mx = (nwg + G - 1) / G, mine = (nwg > bx) ? (nwg - bx + G - 1) / G : 0; if (rep_ == 0 && mine < mx) DRAIN(l, (mx - mine) * PULLS_PER_UNIT); } }
            SEAM(P + 0);
        }
        if (EN(3) && IN(P + 1)) {
            LAS char* alds = (LAS char*)ring; bf16_t* QKV = WSP(bf16_t, WS_QKV); bf16_t* OB = WSP(bf16_t, WS_O); float* STASH = WSP(float, WS_STASH) + (size_t)bx * (64 * 512);
            PHASE_TID(); const int r32 = lane & 31, hh = lane >> 5;
            if (EN(7) && kind == 0) { REP(3) {
                LAS float* wsf = (LAS float*)(alds + 4 * 16384) + wave * 64;
                const int nlat = 512, nall = nlat + (lastl ? 0 : 64);
                for (int u = vcu; u < nall; u += G) {
                    int b, hq, q0, NT, base1;
                    if (u < nlat) { const int qb = u & 7, g = (u >> 3) & 3, kv = (u >> 5) & 1; b = u >> 6; hq = kv * 4 + g; q0 = qb * 256; NT = 36; base1 = 0; }
                    else { const int uc = u - nlat; hq = uc & 7; b = uc >> 3; q0 = 2048; NT = 4; base1 = 2048; }
                    const int kv = hq >> 2; const size_t rb = (size_t)b * TPB;
                    f32x16 o[4]; float m, lsum;
                    att::attn_core<128, 128, false>(opaque(QKV) + (rb + q0) * 1536 + hq * 128, 1536, opaque(QKV) + rb * 1536 + 1024 + kv * 128, opaque(QKV) + rb * 1536 + 1280 + kv * 128, 1536, NT, NT, base1, 0, 0, alds, o, m, lsum);
                    float rl[16]; att::row_bcast(wsf, 1.0f / lsum, r32, hh, rl);
                    bf16_t* Ow = opaque(OB) + (rb + q0 + wave * 32) * DM + hq * 128 + r32;
#pragma unroll
                    for (int r = 0; r < 16; ++r) { const int orow = att::crow(r, hh);
#pragma unroll
                        for (int d0 = 0; d0 < 4; ++d0) Ow[(size_t)orow * DM + d0 * 32] = (bf16_t)(cvt_pk_bf16(o[d0][r] * rl[r], 0.f) & 0xffffu); }
                }
            } } else if (EN(8) && kind == 1) { REP(4) {
                LAS float* wsf = (LAS float*)(alds + 4 * 8192) + wave * 64;
                const float* sink = opaque(args.in[13]);
                const int nlat = 1024, nall = nlat + (lastl ? 0 : 128);
                for (int u = vcu; u < nall; u += G) {
                    int b, hq, q0, NT, base2;
                    if (u < nlat) { const int qb = ((u & 7) + 2 * (u >> 8)) & 7, g = (u >> 3) & 3, kv = (u >> 5) & 3; b = (u >> 7) & 7; hq = kv * 4 + g; q0 = qb * 256;
                        const int klo = (q0 - 128) < 0 ? 0 : q0 - 128, khi = (q0 + 384) > SEQ ? SEQ : q0 + 384; base2 = klo; NT = 4 + (khi - klo) / 64; }
                    else { const int uc = u - nlat; hq = uc & 15; b = uc >> 4; q0 = 2048; NT = 4; base2 = 0; }
                    const int kv = hq >> 2; const size_t rb = (size_t)b * TPB;
                    f32x16 o[2]; float m, lsum;
                    att::attn_core<64, 64, true>(opaque(QKV) + (rb + q0) * 1536 + hq * 64, 1536, opaque(QKV) + rb * 1536 + 1024 + kv * 64, opaque(QKV) + rb * 1536 + 1280 + kv * 64, 1536, NT, 4, 2048, base2, q0, alds, o, m, lsum);
                    lsum += exp2f(sink[hq] * 1.4426950408889634f - m * (0.125f * 1.4426950408889634f));
                    float rl[16]; att::row_bcast(wsf, 1.0f / lsum, r32, hh, rl);
                    bf16_t* Ow = opaque(OB) + (rb + q0 + wave * 32) * DM + hq * 64 + r32;
#pragma unroll
                    for (int r = 0; r < 16; ++r) { const int orow = att::crow(r, hh);
#pragma unroll
                        for (int d0 = 0; d0 < 2; ++d0) Ow[(size_t)orow * DM + d0 * 32] = (bf16_t)(cvt_pk_bf16(o[d0][r] * rl[r], 0.f) & 0xffffu); }
                }
            } } else if (EN(9) && kind == 2) { REP(5) {
                LAS float* wsf = (LAS float*)(alds + 2 * 16384 + 2 * 8192) + wave * 64;
                const float lam = expf(wave_sum(opaque(args.in[16])[lane] * opaque(args.in[17])[lane])) - expf(wave_sum(opaque(args.in[18])[lane] * opaque(args.in[19])[lane])) + LAM_INIT_C;
                const float* sg = opaque(args.in[20]);
                const int nlat = 512, nall = nlat + (lastl ? 0 : 64);
                for (int u = vcu; u < nall; u += G) {
                    int b, h, q0, NT, base1;
                    if (u < nlat) { const int qb = u & 7; h = (u >> 3) & 7; b = u >> 6; q0 = qb * 256; NT = 36; base1 = 0; }
                    else { const int uc = u - nlat; h = uc & 7; b = uc >> 3; q0 = 2048; NT = 4; base1 = 2048; }
                    const size_t rb = (size_t)b * TPB;
#pragma unroll 1
                    for (int mp = 0; mp < 2; ++mp) {
                        f32x16 o[4]; float m, lsum; float rl[16];
                        att::attn_core<64, 128, false>(opaque(QKV) + (rb + q0) * 3072 + h * 128 + mp * 64, 3072, opaque(QKV) + rb * 3072 + 1024 + h * 128 + mp * 64, opaque(QKV) + rb * 3072 + 2048 + h * 128, 3072, NT, NT, base1, 0, 0, alds, o, m, lsum);
                        att::row_bcast(wsf, 1.0f / lsum, r32, hh, rl);
                        float* st = opaque(STASH) + tid;
                        if (mp == 0) {
#pragma unroll
                            for (int d0 = 0; d0 < 4; ++d0)
#pragma unroll
                                for (int r = 0; r < 16; ++r) st[(d0 * 16 + r) * 512] = o[d0][r] * rl[r];
                        } else {
                            const f32x4 gv = (f32x4){sg[r32], sg[32 + r32], sg[64 + r32], sg[96 + r32]};
                            bf16_t* Ow = opaque(OB) + (rb + q0 + wave * 32) * DM + h * 128 + r32;
#pragma unroll
                            for (int r = 0; r < 16; ++r) { float v[4]; float ss = 0.f;
#pragma unroll
                                for (int d0 = 0; d0 < 4; ++d0) { v[d0] = st[(d0 * 16 + r) * 512] - lam * (o[d0][r] * rl[r]); ss += v[d0] * v[d0]; }
                                ss = lane_xor_add<1>(ss); ss = lane_xor_add<2>(ss); ss = lane_xor_add<4>(ss); ss = lane_xor_add<8>(ss); ss = lane_xor_add<16>(ss);
                                const float rinv = (1.0f - LAM_INIT_C) / sqrtf(ss * (1.0f / 128.0f) + RMS_EPS); const int orow = att::crow(r, hh);
#pragma unroll
                                for (int d0 = 0; d0 < 4; ++d0) Ow[(size_t)orow * DM + d0 * 32] = (bf16_t)(cvt_pk_bf16(v[d0] * rinv * gv[d0], 0.f) & 0xffffu);
                                if ((r & 3) == 3) asm volatile("" ::: "memory"); }
                        }
                    }
                }
            } }
            SEAM(P + 1);
        }
        if (EN(4) && IN(P + 2)) { REP(6) {
            if (PSEL >= 60 && PSEL < 64 && l == PSEL - 60) pacc += (unsigned)__builtin_amdgcn_readfirstlane((int)__hip_atomic_load((unsigned*)opaque(ws) + CW_Q + l * 64, RLX_AGENT));
            DenseSched S; S.init(WSP(bf16_t, WS_O), WSP(bf16_t, WS_WO) + (size_t)l * 1024 * 1024, 1024, lastl ? 64 : 72, 4, G, bx, lastl ? 1 : 0);
            EpiWo E{WSP(float, WS_X), WSP(float, WS_Y), MODL, (l == 0) ? opaque(args.in[0]) : nullptr, (l == 0) ? opaque(args.in[2]) : nullptr};
            pg8::gemm_phase(ring, 1024, S, E);
            if (rep_ == 0) DRAIN(l, -1); }
            SEAM(P + 2);
        }
        if (EN(5) && IN(P + 3)) { REP(9) {
            const float* lg = opaque(args.in[6] + (size_t)(l * 2 + 0) * 1024); const float* lb = opaque(args.in[7] + (size_t)(l * 2 + 0) * 1024);
            const float* wr = WSP(float, WS_WR) + (size_t)l * 36 * 1024; const float* bg = opaque(args.in[23] + l * 4); const float* be = opaque(args.in[25] + l * 32);
            float* X = WSP(float, WS_X); float* Y = WSP(float, WS_Y); bf16_t* HB = WSP(bf16_t, WS_HB); const float* modl = MODL; u32x4* TOK = WSP(u32x4, WS_TOK); int* LIST = WSP(int, WS_LIST); unsigned* cnt = CNTL;
            PHASE_TID();
            unsigned long long tp0_ = 0, tp1_ = 0, tp2_ = 0; if (PSEL >= 41 && PSEL <= 43) tp0_ = __builtin_amdgcn_s_memrealtime();
            LAS unsigned* RI = (LAS unsigned*)(lds + RI_OFF); LAS unsigned* lc = RI + 128 * 8; LAS unsigned* gb = lc + 32;
            LAS float* WL = (LAS float*)ring;
            __syncthreads();
            if (tid < 128) RI[tid * 8] = 0xffffffffu; if (tid < 32) lc[tid] = 0u;
            { f32x4 wv[18];
#pragma unroll
              for (int i = 0; i < 18; ++i) wv[i] = ((const f32x4*)wr)[tid + 512 * i];
#pragma unroll
              for (int i = 0; i < 18; ++i) ((LAS f32x4*)WL)[tid + 512 * i] = wv[i]; }
            __syncthreads();
            if (PSEL >= 41 && PSEL <= 43) tp1_ = __builtin_amdgcn_s_memrealtime();
            constexpr int RB = 3;
            int nslot = wave * 16;
            const int RPW = MROWS / NGW;
            const int rend = (gw + 1) * RPW;
#define ROWC(r) ((((r) < rend) && !(lastl && ((r) % TPB) >= SEQ)) ? (r) : 0)
            f32x4 y[RB][4], yn[RB][4];
#pragma unroll
            for (int k = 0; k < RB; ++k) { const int rc = ROWC(gw * RPW + k);
#pragma unroll
                for (int j = 0; j < 4; ++j) y[k][j] = *(const f32x4*)(Y + (size_t)rc * DM + 4 * lane + 256 * j); }
            for (int r0 = gw * RPW; r0 < rend; r0 += RB, nslot += RB) {
                int row[RB]; bool ok[RB]; const float* mv[RB];
#pragma unroll
                for (int k = 0; k < RB; ++k) { const int r = r0 + k; const int t = r % TPB; ok[k] = (r < rend) && !(lastl && t >= SEQ); row[k] = ok[k] ? r : 0;
                    const int b = row[k] / TPB; mv[k] = modl + (size_t)(((row[k] % TPB) >= SEQ) ? 8 : b) * 6144; }
#pragma unroll
                for (int k = 0; k < RB; ++k) { const int rc = ROWC(r0 + RB + k);
#pragma unroll
                    for (int j = 0; j < 4; ++j) yn[k][j] = *(const f32x4*)(Y + (size_t)rc * DM + 4 * lane + 256 * j); }
                float s[RB];
#pragma unroll
                for (int k = 0; k < RB; ++k) { s[k] = 0.f;
#pragma unroll
                    for (int j = 0; j < 4; ++j) s[k] += (y[k][j][0] + y[k][j][1]) + (y[k][j][2] + y[k][j][3]); }
                float s2[RB];
#pragma unroll
                for (int k = 0; k < RB; ++k) { const float mean = wave_sum(s[k]) * (1.0f / 1024.0f); s2[k] = 0.f;
#pragma unroll
                    for (int j = 0; j < 4; ++j) { y[k][j] = y[k][j] - mean; s2[k] += (y[k][j][0] * y[k][j][0] + y[k][j][1] * y[k][j][1]) + (y[k][j][2] * y[k][j][2] + y[k][j][3] * y[k][j][3]); } }
                float rstd[RB];
#pragma unroll
                for (int k = 0; k < RB; ++k) rstd[k] = 1.0f / sqrtf(wave_sum(s2[k]) * (1.0f / 1024.0f) + LN_EPS);
#pragma unroll
                for (int j = 0; j < 4; ++j) { const int c = 4 * lane + 256 * j; const f32x4 gq = *(const f32x4*)(lg + c), bq = *(const f32x4*)(lb + c);
#pragma unroll
                    for (int k = 0; k < RB; ++k) {
                        const f32x4 xn = y[k][j] * rstd[k] * gq + bq;
                        const f32x4 hv = xn * (*(const f32x4*)(mv[k] + 4096 + c) + 1.0f) + *(const f32x4*)(mv[k] + 3072 + c);
                        y[k][j] = hv;
                        if (ok[k]) { *(f32x4*)(X + (size_t)row[k] * DM + c) = xn;
                            u32x2 w; w.x = cvt_pk_bf16(hv[0], hv[1]); w.y = cvt_pk_bf16(hv[2], hv[3]); *(u32x2*)(HB + (size_t)row[k] * DM + c) = w; } } }
                float gl[RB][4];
#pragma unroll
                for (int e = 0; e < 4; ++e) { float p[RB];
#pragma unroll
                    for (int k = 0; k < RB; ++k) p[k] = 0.f;
#pragma unroll
                    for (int j = 0; j < 4; ++j) { const f32x4 w = *(const LAS f32x4*)(WL + e * 1024 + 4 * lane + 256 * j);
#pragma unroll
                        for (int k = 0; k < RB; ++k) p[k] += (y[k][j][0] * w[0] + y[k][j][1] * w[1]) + (y[k][j][2] * w[2] + y[k][j][3] * w[3]); }
#pragma unroll
                    for (int k = 0; k < RB; ++k) gl[k][e] = wave_sum(p[k]) + bg[e]; }
                int gsel[RB]; float gprob[RB];
#pragma unroll
                for (int k = 0; k < RB; ++k) { gsel[k] = 0; float gmax = gl[k][0];
#pragma unroll
                    for (int e = 1; e < 4; ++e) if (gl[k][e] > gmax) { gmax = gl[k][e]; gsel[k] = e; }
                    float gden = 0.f;
#pragma unroll
                    for (int e = 0; e < 4; ++e) gden += expf(gl[k][e] - gmax);
                    gprob[k] = 1.0f / gden; }
                float el[RB][8];
#pragma unroll
                for (int k = 0; k < RB; ++k) { const LAS float* wp0 = WL + (4 + gsel[k] * 8) * 1024 + 4 * lane;
#pragma unroll
                    for (int e = 0; e < 8; ++e) { float p = 0.f;
#pragma unroll
                        for (int j = 0; j < 4; ++j) { const f32x4 w = *(const LAS f32x4*)(wp0 + e * 1024 + 256 * j); p += (y[k][j][0] * w[0] + y[k][j][1] * w[1]) + (y[k][j][2] * w[2] + y[k][j][3] * w[3]); }
                        el[k][e] = p; } }
#pragma unroll
                for (int k = 0; k < RB; ++k)
#pragma unroll
                    for (int e = 0; e < 8; ++e) el[k][e] = wave_sum(el[k][e]) + be[gsel[k] * 8 + e];
#pragma unroll
                for (int k = 0; k < RB; ++k) {
                    int i1 = 0; float v1 = el[k][0];
#pragma unroll
                    for (int e = 1; e < 8; ++e) if (el[k][e] > v1) { v1 = el[k][e]; i1 = e; }
                    int i2 = -1; float v2 = -3.0e38f;
#pragma unroll
                    for (int e = 0; e < 8; ++e) if (e != i1 && el[k][e] > v2) { v2 = el[k][e]; i2 = e; }
                    const float ex = expf(v2 - v1), w1 = gprob[k] / (1.0f + ex), w2 = gprob[k] * ex / (1.0f + ex);
                    if (lane == 0 && ok[k]) {
                        const int e1 = gsel[k] * 8 + i1, e2 = gsel[k] * 8 + i2;
                        const unsigned p1 = __hip_atomic_fetch_add(lc + e1, 1u, __ATOMIC_RELAXED, __HIP_MEMORY_SCOPE_WORKGROUP), p2 = __hip_atomic_fetch_add(lc + e2, 1u, __ATOMIC_RELAXED, __HIP_MEMORY_SCOPE_WORKGROUP);
                        LAS unsigned* ri = RI + (nslot + k) * 8;
                        ri[0] = (unsigned)row[k]; ri[1] = (unsigned)e1 | (p1 << 8); ri[2] = __float_as_uint(w1); ri[3] = (unsigned)e2 | (p2 << 8); ri[4] = __float_as_uint(w2);
                    }
                }
#pragma unroll
                for (int k = 0; k < RB; ++k)
#pragma unroll
                    for (int j = 0; j < 4; ++j) y[k][j] = yn[k][j];
            }
#undef ROWC
            __syncthreads();
            if (PSEL >= 41 && PSEL <= 43) tp2_ = __builtin_amdgcn_s_memrealtime();
            if (tid < 32 && rep_ == 0) { const unsigned n = lc[tid]; gb[tid] = n ? atomicAdd(cnt + tid * 64, n) : 0u; }
            __syncthreads();
            if (tid < 128 && rep_ == 0) { const unsigned r = RI[tid * 8];
                if (r != 0xffffffffu) { const unsigned a1 = RI[tid * 8 + 1], a2 = RI[tid * 8 + 3]; const unsigned e1 = a1 & 255u, e2 = a2 & 255u, p1 = gb[e1] + (a1 >> 8), p2 = gb[e2] + (a2 >> 8);
                    LIST[(size_t)e1 * MROWS + p1] = (int)r; LIST[(size_t)e2 * MROWS + p2] = (int)r;
                    TOK[r] = (u32x4){e1 | (p1 << 8), RI[tid * 8 + 2], e2 | (p2 << 8), RI[tid * 8 + 4]}; }
            }
            if (PSEL >= 41 && PSEL <= 43) { asm volatile("s_waitcnt vmcnt(0)" ::: "memory"); const unsigned long long tp3_ = __builtin_amdgcn_s_memrealtime(); pacc += (PSEL == 41) ? tp1_ - tp0_ : (PSEL == 42) ? tp2_ - tp1_ : tp3_ - tp2_; } }
            SEAM(P + 3);
        }
        if (IN(P + 4) || IN(P + 5) || IN(P + 6)) {
            PHASE_TID();
            __syncthreads();
            if (tid < 32) tab[tid] = (int)__hip_atomic_load((GAS unsigned*)CNTL + tid * 64, RLX_AGENT);
            __syncthreads();
            if (tid == 0) { int p = 0; for (int e = 0; e < 32; ++e) { tab[32 + e] = p; p += (tab[e] + 255) >> 8; } tab[64] = p; }
            __syncthreads();
        }
        if (EN(6) && IN(P + 4)) { REP(7) {
            MoeGuSched S{(const char*)WSP(bf16_t, WS_HB), (const char*)(WSP(bf16_t, WS_WGU) + (size_t)l * 32 * 1024 * 1024), WSP(int, WS_LIST), tab, G, vcu};
            EpiGU E{WSP(bf16_t, WS_HID)};
            pg8::gemm_phase(ring, 1024, S, E);
            if (rep_ == 0 && !lastl) { const int nwg = 4 * tab[64], mx = (nwg + G - 1) / G, mine = (nwg > vcu) ? (nwg - vcu + G - 1) / G : 0; if (mine < mx) DRAIN(l + 1, (mx - mine) * PULLS_PER_UNIT); } }
            SEAM(P + 4);
        }
        if (EN(6) && IN(P + 5)) { REP(8) {
            MoeDownSched S{(const char*)WSP(bf16_t, WS_HID), (const char*)(WSP(bf16_t, WS_WD) + (size_t)l * 32 * 1024 * 512), tab, G, vcu};
            EpiDown E{WSP(bf16_t, WS_YS)};
            pg8::gemm_phase(ring, 512, S, E);
            if (rep_ == 0 && !lastl) { const int nwg = 4 * tab[64], mx = (nwg + G - 1) / G, mine = (nwg > vcu) ? (nwg - vcu + G - 1) / G : 0; if (mine < mx) DRAIN(l + 1, (mx - mine) * (PULLS_PER_UNIT / 2)); } }
            SEAM(P + 5);
        }
        if (EN(5) && IN(P + 6)) { REP(10) {
            const float* lg = opaque(args.in[6] + (size_t)(l * 2 + 1) * 1024); const float* lb = opaque(args.in[7] + (size_t)(l * 2 + 1) * 1024);
            float* X = WSP(float, WS_X); bf16_t* HB = WSP(bf16_t, WS_HB); const float* modl = MODL; u32x4* TOK = WSP(u32x4, WS_TOK); bf16_t* YS = WSP(bf16_t, WS_YS); float* MOD = WSP(float, WS_MOD); float* outp = opaque(args.out);
            float* Xo = rep_ ? WSP(float, WS_Y) : X; bf16_t* HBo = rep_ ? WSP(bf16_t, WS_STASH) : HB; if (rep_) outp = WSP(float, WS_Y);
            PHASE_TID();
            constexpr int RB = 3;
            const int RPW = MROWS / NGW;
            LAS float* VL = (LAS float*)ring;
            { const int bwg = (gw * RPW) / TPB; const int ln = lastl ? l : l + 1;
              __syncthreads();
              for (int i = tid; i < 8 * 256; i += 512) { const int v = i >> 8, c4 = (i & 255) * 4; const float* src;
                  if (v == 0) src = lg; else if (v == 1) src = lb; else { const int bb = (v < 5) ? bwg : 8, q = (v - 2) % 3;
                      src = (q == 0) ? modl + (size_t)bb * 6144 + 5120 : MOD + ((size_t)ln * 9 + bb) * 6144 + (q == 1 ? 0 : 1024); }
                  *(LAS f32x4*)(VL + v * 1024 + c4) = *(const f32x4*)(src + c4); }
              __syncthreads(); }
            const int rbase = bx * 8 * RPW, rbeg = gw * RPW, rend = rbeg + RPW;
#define ROWC(r) ((((r) < rend) && !(lastl && ((r) % TPB) >= SEQ)) ? (r) : 0)
            LAS u32x4* TK = (LAS u32x4*)(VL + 8 * 1024);
            if (tid < 8 * RPW) { const int r = rbase + tid; const int rc = (lastl && (r % TPB) >= SEQ) ? 0 : r; TK[tid] = TOK[rc]; }
            __syncthreads();
#define P7_LOAD(XR, AR, BR, W1, W2, R0) do { _Pragma("unroll") for (int k = 0; k < RB; ++k) { const int r_ = (R0) + k, rc_ = ROWC(r_); const u32x4 tk = TK[(r_ < rend ? r_ : rbeg) - rbase]; \
                const int e1 = tk.x & 255, p1 = tk.x >> 8, e2 = tk.z & 255, p2 = tk.z >> 8; W1[k] = __uint_as_float(tk.y); W2[k] = __uint_as_float(tk.w); \
                const bf16_t* ya_ = YS + ((size_t)tab[32 + e1] * 256 + p1) * DM; const bf16_t* yb_ = YS + ((size_t)tab[32 + e2] * 256 + p2) * DM; \
                _Pragma("unroll") for (int j = 0; j < 4; ++j) { const int c = 4 * lane + 256 * j; XR[k][j] = *(const f32x4*)(X + (size_t)rc_ * DM + c); AR[k][j] = *(const u32x2*)(ya_ + c); BR[k][j] = *(const u32x2*)(yb_ + c); } } } while (0)
            f32x4 xr[RB][4], xn_[RB][4]; u32x2 ar[RB][4], br[RB][4], an_[RB][4], bn_[RB][4]; float w1[RB], w2[RB], w1n[RB], w2n[RB];
            P7_LOAD(xr, ar, br, w1, w2, rbeg);
            for (int r0 = rbeg; r0 < rend; r0 += RB) {
                int row[RB]; bool ok[RB]; int bbk[RB];
#pragma unroll
                for (int k = 0; k < RB; ++k) { const int r = r0 + k; const int t = r % TPB; ok[k] = (r < rend) && !(lastl && t >= SEQ); row[k] = ok[k] ? r : 0;
                    bbk[k] = ((row[k] % TPB) >= SEQ) ? 5 : 2; }
                P7_LOAD(xn_, an_, bn_, w1n, w2n, r0 + RB);
                f32x4 y[RB][4]; float s[RB];
#pragma unroll
                for (int k = 0; k < RB; ++k) { s[k] = 0.f; const LAS float* g2 = VL + bbk[k] * 1024;
#pragma unroll
                    for (int j = 0; j < 4; ++j) { const int c = 4 * lane + 256 * j;
                        const u32x2 a = ar[k][j], bq = br[k][j];
                        f32x4 f; f[0] = w1[k] * __uint_as_float(a.x << 16) + w2[k] * __uint_as_float(bq.x << 16); f[1] = w1[k] * __uint_as_float(a.x & 0xffff0000u) + w2[k] * __uint_as_float(bq.x & 0xffff0000u);
                        f[2] = w1[k] * __uint_as_float(a.y << 16) + w2[k] * __uint_as_float(bq.y << 16); f[3] = w1[k] * __uint_as_float(a.y & 0xffff0000u) + w2[k] * __uint_as_float(bq.y & 0xffff0000u);
                        y[k][j] = xr[k][j] * ALPHA + *(const LAS f32x4*)(g2 + c) * f;
                        s[k] += (y[k][j][0] + y[k][j][1]) + (y[k][j][2] + y[k][j][3]); } }
                float s2[RB];
#pragma unroll
                for (int k = 0; k < RB; ++k) { const float mean = wave_sum(s[k]) * (1.0f / 1024.0f); s2[k] = 0.f;
#pragma unroll
                    for (int j = 0; j < 4; ++j) { y[k][j] = y[k][j] - mean; s2[k] += (y[k][j][0] * y[k][j][0] + y[k][j][1] * y[k][j][1]) + (y[k][j][2] * y[k][j][2] + y[k][j][3] * y[k][j][3]); } }
                float rstd[RB];
#pragma unroll
                for (int k = 0; k < RB; ++k) rstd[k] = 1.0f / sqrtf(wave_sum(s2[k]) * (1.0f / 1024.0f) + LN_EPS);
#pragma unroll
                for (int j = 0; j < 4; ++j) { const int c = 4 * lane + 256 * j; const f32x4 gq = *(const LAS f32x4*)(VL + c), bq = *(const LAS f32x4*)(VL + 1024 + c);
#pragma unroll
                    for (int k = 0; k < RB; ++k) { if (!ok[k]) continue;
                        const f32x4 xn = y[k][j] * rstd[k] * gq + bq;
                        if (!lastl) { *(f32x4*)(Xo + (size_t)row[k] * DM + c) = xn;
                            const LAS float* mvn = VL + (bbk[k] + 1) * 1024;
                            const f32x4 hv = xn * (*(const LAS f32x4*)(mvn + 1024 + c) + 1.0f) + *(const LAS f32x4*)(mvn + c);
                            u32x2 w; w.x = cvt_pk_bf16(hv[0], hv[1]); w.y = cvt_pk_bf16(hv[2], hv[3]); *(u32x2*)(HBo + (size_t)row[k] * DM + c) = w; }
                        else { const int b = row[k] / TPB, t = row[k] % TPB; *(f32x4*)(outp + ((size_t)b * SEQ + t) * DM + c) = xn; } } }
#pragma unroll
                for (int k = 0; k < RB; ++k) { w1[k] = w1n[k]; w2[k] = w2n[k];
#pragma unroll
                    for (int j = 0; j < 4; ++j) { xr[k][j] = xn_[k][j]; ar[k][j] = an_[k][j]; br[k][j] = bn_[k][j]; } }
            }
#undef ROWC
#undef P7_LOAD
            }
            SEAM(P + 6);
        }
    }
    if (PSEL) {
        const unsigned long long te = __builtin_amdgcn_s_memrealtime();
        if (PSEL >= 10 && PSEL < 30 && PSEL - 10 == 9) pacc += te - t_prev;
        xcd_barrier(bar);
        if (blockIdx.x == 0 && threadIdx.x == 0) {
            unsigned long long v = pacc;
            if (PSEL == 1) { v = 0; for (int k = 0; k < NPHASE - 1; ++k) v += 0x40000000u - __hip_atomic_load(ctl + CW_PROBE + k, RLX_AGENT); }
            if (PSEL == 2) { v = 0; for (int k = 0; k < NPHASE - 1; ++k) v += __hip_atomic_load(ctl + CW_PROBE + 64 + k, RLX_AGENT) / gridDim.x; }
            const unsigned long long t0 = __builtin_amdgcn_s_memrealtime();
            while (__builtin_amdgcn_s_memrealtime() - t0 < v * PMUL) __builtin_amdgcn_s_sleep(32);
        }
    }
#undef IN
#undef SEAM
}

extern "C" void kernel_launch(void* const* d_in, const int* in_sizes, int n_in, void* d_out, int out_size, void* d_ws, size_t ws_size, hipStream_t stream) {
    static int grid = 0;
    if (grid == 0) {
        if (n_in != 29 || in_sizes[0] != NB * SEQ * DM || out_size != NB * SEQ * DM || ws_size < WS_END) { fprintf(stderr, "kernel_launch: unexpected shapes / workspace (n_in %d, ws %zu)\n", n_in, ws_size); grid = -1; return; }
        int dev = 0, cus = 0, per_cu = 0;
        if (hipGetDevice(&dev) != hipSuccess || hipDeviceGetAttribute(&cus, hipDeviceAttributeMultiprocessorCount, dev) != hipSuccess) { grid = -1; return; }
        if (hipFuncSetAttribute((const void*)fwd, hipFuncAttributeMaxDynamicSharedMemorySize, LDS_BYTES) != hipSuccess) { fprintf(stderr, "kernel_launch: hipFuncSetAttribute failed\n"); grid = -1; return; }
        if (hipOccupancyMaxActiveBlocksPerMultiprocessor(&per_cu, (const void*)fwd, 512, LDS_BYTES) != hipSuccess || per_cu < 1) fprintf(stderr, "kernel_launch: occupancy query says %d\n", per_cu);
        (void)hipGetLastError();
        grid = cus;
    }
    if (grid < 0) return;
    if (hipMemsetAsync((char*)d_ws + WS_CTL, 0, CTL_ZERO_BYTES, stream) != hipSuccess) return;
    Args a{};
    for (int i = 0; i < 29; ++i) a.in[i] = (const float*)d_in[i];
    a.out = (float*)d_out; a.ws = (unsigned char*)d_ws;
    if (MK_N_LAUNCHES == 1) { a.ph_lo = 0; a.ph_hi = NPHASE; hipLaunchKernelGGL(fwd, dim3(grid), dim3(512), LDS_BYTES, stream, a); }
    else for (int p = 0; p < NPHASE; ++p) { a.ph_lo = p; a.ph_hi = p + 1; hipLaunchKernelGGL(fwd, dim3(grid), dim3(512), LDS_BYTES, stream, a); }
    const hipError_t le = hipPeekAtLastError();
    if (le != hipSuccess) fprintf(stderr, "kernel_launch: launch failed: %s\n", hipGetErrorName(le));
}
```
